# Optimizing an MI355X kernel written in HIP

```python
import jax
import jax.numpy as jnp
from jax import lax
import numpy as np

D_MODEL = 1024
BATCH = 16
SEQ = 2048
DEPTH = 2

GRID_W = 64
CTX_LEN = 256
D_MIX = D_MODEL
HEAD_DIM = 64
RW_W = D_MIX // 4
RW_H = RW_W // HEAD_DIM
RW_DH = HEAD_DIM
RW_LW = 64
RW_LA = 64
RW_LG = 128
NA_W = D_MIX // 2
NA_H = NA_W // HEAD_DIM
NA_KR = 8
NA_KC = 16
SC_W = D_MIX - RW_W - NA_W
SC_K = 3
PEER_H = 8
PEER_NKEYS = 128
PEER_N = PEER_NKEYS * PEER_NKEYS
PEER_DQ = 256
PEER_TOPK = 16
PEER_CHUNK = 128

NORM_EPS = 1e-6
GN_EPS = 64e-5
NEG_INF = -1e30
IN_SPLITS = (RW_W, RW_W, RW_W, 2 * RW_LW, 2 * RW_LA, RW_LG, NA_W, NA_W, NA_W, SC_W, SC_W, SC_W)
D_IN = sum(IN_SPLITS)

kernel_name = 'hybrid_rwkv7_natten_shortconv_peer_dit'


def rmsnorm(x, g):
    xf = x.astype(jnp.float32)
    y = xf * lax.rsqrt(jnp.mean(xf * xf, axis=-1, keepdims=True) + NORM_EPS)
    return (y * g.astype(jnp.float32)).astype(x.dtype)


def split_columns(z):
    offsets = [int(o) for o in np.cumsum(IN_SPLITS)[:-1]]
    return jnp.split(z, offsets, axis=-1)


def short_conv3(u, w):
    up = jnp.pad(u, ((0, 0), (1, 1), (0, 0)))
    return up[:, :-2] * w[0] + up[:, 1:-1] * w[1] + up[:, 2:] * w[2]


def gated_short_conv(z_b, z_c, z_x, w):
    return z_b * short_conv3(z_c * z_x, w)


def rwkv_prepare(z_r, z_k, z_v, z_w, z_a, w0, w_up, a0, a_up, k_k, k_a):
    f32 = jnp.float32
    B, T, _ = z_r.shape
    r, k, v = z_r.astype(f32), z_k.astype(f32), z_v.astype(f32)
    lw = jnp.tanh(z_w.astype(f32).reshape(B, T, 2, RW_LW))
    la = z_a.astype(f32).reshape(B, T, 2, RW_LA)
    w_raw = w0 + jnp.einsum('btdr,drc->btdc', lw, w_up)
    decay = jnp.exp(-jnp.exp(-jax.nn.softplus(-w_raw) - 0.5))
    a = jax.nn.sigmoid(a0 + jnp.einsum('btdr,drc->btdc', la, a_up))
    kk = (k * k_k).reshape(B, T, RW_H, RW_DH)
    kk = (kk * lax.rsqrt(jnp.sum(kk * kk, axis=-1, keepdims=True) + 1e-12)).reshape(B, T, RW_W)
    k_dir = k[:, :, None, :] * (1.0 + (a - 1.0) * k_a)
    b_dir = kk[:, :, None, :] * a
    tm = lambda t: jnp.moveaxis(t.reshape(B, T, RW_H, RW_DH), 1, 0)
    common = (tm(r), tm(kk), tm(v))
    per_dir = tuple((tm(decay[:, :, d]), tm(b_dir[:, :, d]), tm(k_dir[:, :, d])) for d in range(2))
    return common, per_dir


def wkv_scan(state0, r, kk, v, decay, b, k, reverse):
    def step(S, inp):
        r_t, kk_t, v_t, w_t, b_t, k_t = inp
        sa = jnp.einsum('bhij,bhj->bhi', S, kk_t)
        S = S * w_t[:, :, None, :] - sa[..., None] * b_t[:, :, None, :] + v_t[..., None] * k_t[:, :, None, :]
        return S, jnp.einsum('bhij,bhj->bhi', S, r_t)
    return lax.scan(step, state0, (r, kk, v, decay, b, k), reverse=reverse)


def rwkv_output(y_tm, z_r, z_k, z_v, z_g, g_up, r_k, lnx_g):
    f32 = jnp.float32
    B, T, _ = z_r.shape
    y = jnp.moveaxis(y_tm, 0, 1)
    mu = jnp.mean(y, axis=-1, keepdims=True)
    var = jnp.mean(jnp.square(y - mu), axis=-1, keepdims=True)
    y = (y - mu) * lax.rsqrt(var + GN_EPS) * lnx_g.astype(f32).reshape(RW_H, RW_DH)
    hd = lambda t: t.astype(f32).reshape(B, T, RW_H, RW_DH)
    r, k, v = hd(z_r), hd(z_k), hd(z_v)
    y = y + jnp.sum(r * k * r_k, axis=-1, keepdims=True) * v
    gate = jax.nn.sigmoid(z_g.astype(f32)) @ g_up.astype(f32)
    return (y.reshape(B, T, RW_W) * gate).astype(z_r.dtype)


def rwkv_mixer(pc, pl, w0, w_up, a0, a_up, g_up, k_k, k_a, r_k, lnx_g, need_ctx):
    c_common, c_dirs = rwkv_prepare(*pc[:5], w0, w_up, a0, a_up, k_k, k_a)
    l_common, l_dirs = rwkv_prepare(*pl[:5], w0, w_up, a0, a_up, k_k, k_a)
    state0 = jnp.zeros((pl[0].shape[0], RW_H, RW_DH, RW_DH), jnp.float32)
    ys_c, ys_l = [], []
    for d, reverse in enumerate((False, True)):
        ctx_state, y_c = wkv_scan(state0, *c_common, *c_dirs[d], reverse=reverse)
        _, y_l = wkv_scan(ctx_state, *l_common, *l_dirs[d], reverse=reverse)
        ys_c.append(y_c)
        ys_l.append(y_l)
    out_l = rwkv_output(ys_l[0] + ys_l[1], pl[0], pl[1], pl[2], pl[5], g_up, r_k, lnx_g)
    out_c = rwkv_output(ys_c[0] + ys_c[1], pc[0], pc[1], pc[2], pc[5], g_up, r_k, lnx_g) if need_ctx else None
    return out_c, out_l


def neighbourhood_attention(ql, kl, vl, kc, vc, rpb):
    f32 = jnp.float32
    B, S = ql.shape[:2]
    rows = S // GRID_W
    kr = min(NA_KR, rows)
    scale = HEAD_DIM ** -0.5
    grid = lambda t: t.reshape(B, rows, GRID_W, NA_H, HEAD_DIM)
    qg = grid(ql).astype(f32) * scale
    kg, vg = grid(kl).astype(f32), grid(vl)
    ri = jnp.arange(rows)
    row_idx = jnp.clip(ri - kr // 2, 0, rows - kr)[:, None] + jnp.arange(kr)[None, :]
    ci = jnp.arange(GRID_W)
    c0 = jnp.clip(ci - NA_KC // 2, 0, GRID_W - NA_KC)
    col_ok = (ci[None, :] >= c0[:, None]) & (ci[None, :] < c0[:, None] + NA_KC)
    dr = row_idx - ri[:, None] + (NA_KR - 1)
    dc = jnp.clip(ci[None, :] - ci[:, None] + (NA_KC - 1), 0, 2 * NA_KC - 2)
    bias = rpb[:, dr[:, None, :, None], dc[None, :, None, :]].astype(f32)
    k_band = kg[:, row_idx]
    v_band = vg[:, row_idx]
    s_win = jnp.einsum('brqhd,brkwhd->bhrqkw', qg, k_band) + bias[None]
    s_win = jnp.where(col_ok[:, None, :], s_win, NEG_INF)
    s_ctx = jnp.einsum('brqhd,bnhd->bhrqn', qg, kc.astype(f32))
    n_win = kr * GRID_W
    s = jnp.concatenate([s_win.reshape(B, NA_H, rows, GRID_W, n_win), s_ctx], axis=-1)
    p = jax.nn.softmax(s, axis=-1)
    p_win = p[..., :n_win].reshape(B, NA_H, rows, GRID_W, kr, GRID_W).astype(vl.dtype)
    p_ctx = p[..., n_win:].astype(vl.dtype)
    out = jnp.einsum('bhrqkw,brkwhd->brqhd', p_win, v_band) + jnp.einsum('bhrqn,bnhd->brqhd', p_ctx, vc)
    return out.reshape(B, S, NA_W)


def context_attention(qc, kc, vc):
    f32 = jnp.float32
    B, C = qc.shape[:2]
    s = jnp.einsum('bqhd,bkhd->bhqk', qc.astype(f32), kc.astype(f32)) * (HEAD_DIM ** -0.5)
    p = jax.nn.softmax(s, axis=-1).astype(vc.dtype)
    return jnp.einsum('bhqk,bkhd->bqhd', p, vc).reshape(B, C, NA_W)


def token_mixing(hc, hl, w_in, w_out, rw_w0, rw_w_up, rw_a0, rw_a_up, rw_g_up, rw_k_k, rw_k_a,
                 rw_r_k, rw_lnx_g, na_rpb, sc_conv_w, need_ctx):
    B, S = hl.shape[:2]
    C = hc.shape[1]
    pc = split_columns(hc @ w_in)
    pl = split_columns(hl @ w_in)
    y_rw_c, y_rw_l = rwkv_mixer(pc, pl, rw_w0, rw_w_up, rw_a0, rw_a_up, rw_g_up, rw_k_k, rw_k_a,
                                rw_r_k, rw_lnx_g, need_ctx)
    qc, kc, vc = (t.reshape(B, C, NA_H, HEAD_DIM) for t in pc[6:9])
    ql, kl, vl = (t.reshape(B, S, NA_H, HEAD_DIM) for t in pl[6:9])
    y_na_l = neighbourhood_attention(ql, kl, vl, kc, vc, na_rpb)
    y_sc_l = gated_short_conv(*pl[9:12], sc_conv_w)
    yl = jnp.concatenate([y_rw_l, y_na_l, y_sc_l], axis=-1) @ w_out
    if not need_ctx:
        return None, yl
    y_na_c = context_attention(qc, kc, vc)
    y_sc_c = gated_short_conv(*pc[9:12], sc_conv_w)
    yc = jnp.concatenate([y_rw_c, y_na_c, y_sc_c], axis=-1) @ w_out
    return yc, yl


def peer_ffn(h, q_w, sub_keys, u_tab, v_tab):
    f32 = jnp.float32
    lead = h.shape[:-1]
    t = h.reshape(-1, D_MODEL)
    n = t.shape[0]
    q = (t @ q_w).reshape(n, PEER_H, 2, PEER_DQ // 2)
    s = jnp.einsum('thpd,hpnd->thpn', q.astype(f32), sub_keys.astype(f32))
    s1, i1 = lax.top_k(s[:, :, 0], PEER_TOPK)
    s2, i2 = lax.top_k(s[:, :, 1], PEER_TOPK)
    cand_s = (s1[..., :, None] + s2[..., None, :]).reshape(n, PEER_H, PEER_TOPK * PEER_TOPK)
    cand_i = (i1[..., :, None] * PEER_NKEYS + i2[..., None, :]).reshape(n, PEER_H, PEER_TOPK * PEER_TOPK)
    top_s, pos = lax.top_k(cand_s, PEER_TOPK)
    idx = jnp.take_along_axis(cand_i, pos, axis=-1)
    gates = jax.nn.softmax(top_s, axis=-1).astype(h.dtype)

    def chunk(args):
        x_c, i_c, g_c = args
        act = jax.nn.gelu(jnp.einsum('chkd,cd->chk', u_tab[i_c], x_c))
        return jnp.einsum('chk,chkd->cd', g_c * act, v_tab[i_c])

    nc = n // PEER_CHUNK
    out = lax.map(chunk, (t.reshape(nc, PEER_CHUNK, D_MODEL),
                          idx.reshape(nc, PEER_CHUNK, PEER_H, PEER_TOPK),
                          gates.reshape(nc, PEER_CHUNK, PEER_H, PEER_TOPK)))
    return out.reshape(lead + (D_MODEL,))


def setup_inputs(seed: int = 0) -> dict:
    key = jax.random.key(seed)
    keys = iter(jax.random.split(key, 32))
    nrm = lambda shape, std: std * jax.random.normal(next(keys), shape, jnp.float32)
    L, D = DEPTH, D_MODEL
    return {
        'x': nrm((BATCH, SEQ, D), 1.0),
        'c': nrm((BATCH, D), 1.0),
        'ctx': nrm((BATCH, CTX_LEN, D), 1.0),
        'c_ctx': nrm((D,), 1.0),
        'ada_w': nrm((L, D, 6 * D), 0.5 * D ** -0.5),
        'ada_b': nrm((L, 6 * D), 0.02),
        'norm1_g': 1.0 + nrm((L, D), 0.02),
        'norm2_g': 1.0 + nrm((L, D), 0.02),
        'w_in': nrm((L, D, D_IN), D ** -0.5),
        'rw_w0': jnp.linspace(-5.0, 1.0, RW_W, dtype=jnp.float32) + nrm((L, 2, RW_W), 0.1),
        'rw_w_up': nrm((L, 2, RW_LW, RW_W), 0.5 * RW_LW ** -0.5),
        'rw_a0': nrm((L, 2, RW_W), 0.1),
        'rw_a_up': nrm((L, 2, RW_LA, RW_W), 0.5 * RW_LA ** -0.5),
        'rw_g_up': nrm((L, RW_LG, RW_W), RW_LG ** -0.5),
        'rw_k_k': 0.85 + nrm((L, RW_W), 0.05),
        'rw_k_a': 1.0 + nrm((L, RW_W), 0.05),
        'rw_r_k': nrm((L, RW_H, RW_DH), 0.1),
        'rw_lnx_g': 1.0 + nrm((L, RW_W), 0.02),
        'na_rpb': nrm((L, NA_H, 2 * NA_KR - 1, 2 * NA_KC - 1), 0.1),
        'sc_conv_w': nrm((L, SC_K, SC_W), SC_K ** -0.5),
        'w_out': nrm((L, D_MIX, D), D_MIX ** -0.5),
        'peer_q_w': nrm((L, D, PEER_H * PEER_DQ), D ** -0.5),
        'peer_sub_keys': nrm((L, PEER_H, 2, PEER_NKEYS, PEER_DQ // 2), (PEER_DQ // 2) ** -0.5),
        'peer_u': nrm((L, PEER_N, D), D ** -0.5),
        'peer_v': nrm((L, PEER_N, D), PEER_TOPK ** -0.5),
        'final_g': 1.0 + nrm((D,), 0.02),
    }


def reference(x, c, ctx, c_ctx, ada_w, ada_b, norm1_g, norm2_g, w_in, rw_w0, rw_w_up, rw_a0,
              rw_a_up, rw_g_up, rw_k_k, rw_k_a, rw_r_k, rw_lnx_g, na_rpb, sc_conv_w, w_out,
              peer_q_w, peer_sub_keys, peer_u, peer_v, final_g):
    xl, xc = x, ctx
    for i in range(DEPTH):
        need_ctx = i < DEPTH - 1
        mod_l = jax.nn.silu(c) @ ada_w[i] + ada_b[i]
        mod_c = jax.nn.silu(c_ctx) @ ada_w[i] + ada_b[i]
        sh1, sc1, g1, sh2, sc2, g2 = jnp.split(mod_l[:, None, :], 6, axis=-1)
        csh1, csc1, cg1, csh2, csc2, cg2 = jnp.split(mod_c, 6, axis=-1)
        hl = rmsnorm(xl, norm1_g[i]) * (1.0 + sc1) + sh1
        hc = rmsnorm(xc, norm1_g[i]) * (1.0 + csc1) + csh1
        yc, yl = token_mixing(hc, hl, w_in[i], w_out[i], rw_w0[i], rw_w_up[i], rw_a0[i], rw_a_up[i],
                              rw_g_up[i], rw_k_k[i], rw_k_a[i], rw_r_k[i], rw_lnx_g[i], na_rpb[i],
                              sc_conv_w[i], need_ctx)
        xl = xl + g1 * yl
        hl2 = rmsnorm(xl, norm2_g[i]) * (1.0 + sc2) + sh2
        xl = xl + g2 * peer_ffn(hl2, peer_q_w[i], peer_sub_keys[i], peer_u[i], peer_v[i])
        if need_ctx:
            xc = xc + cg1 * yc
            hc2 = rmsnorm(xc, norm2_g[i]) * (1.0 + csc2) + csh2
            xc = xc + cg2 * peer_ffn(hc2, peer_q_w[i], peer_sub_keys[i], peer_u[i], peer_v[i])
    return rmsnorm(xl, final_g)
```

```cpp
#define REPMASK 0
#include <hip/hip_runtime.h>
#include <hip/hip_cooperative_groups.h>
#include <cstdio>
#include <cstdint>
namespace cg = cooperative_groups;

#define LAS __attribute__((address_space(3)))
typedef unsigned short bf16_t;
typedef short bf16x8 __attribute__((ext_vector_type(8)));
typedef float f32x4 __attribute__((ext_vector_type(4)));
typedef float f32x2 __attribute__((ext_vector_type(2)));
typedef unsigned u32x4 __attribute__((ext_vector_type(4)));
typedef unsigned u32x2 __attribute__((ext_vector_type(2)));

constexpr int D = 1024, NB = 16, SEQ = 2048, CTXL = 256, NLAT = NB * SEQ, NCTX = NB * CTXL, NTOK = NLAT + NCTX;
constexpr int DIN = 3456, DINP = 3584;
constexpr int ZR = 0, ZK = 256, ZV = 512, ZW = 768, ZA = 896, ZG = 1024, ZNQ = 1152, ZNK = 1664, ZNV = 2176, ZSB = 2688, ZSC = 2944, ZSX = 3200;
constexpr int RWW = 256, NAW = 512, SCW = 256;
constexpr int PH = 8, PK = 16, PNK = 128, PDQ = 256, PN = 16384;
constexpr int NWAVES = 8, NTHR = 512;
constexpr int LDS_BYTES = 147456;

constexpr size_t MiB = 1u << 20;
constexpr size_t WS_CTL = 0, WS_MOD = 1 * MiB, WS_WUPT = 2 * MiB, WS_AUPT = 2 * MiB + 512 * 1024, WS_SUBK = 3 * MiB, WS_WIN = 5 * MiB, WS_WOUT = 19 * MiB, WS_QW = 23 * MiB;
constexpr size_t WS_PU = 31 * MiB, WS_YS = 63 * MiB, WS_H = 111 * MiB, WS_XR = 183 * MiB, WS_Z = 255 * MiB, WS_END = 507 * MiB;
constexpr size_t WS_PSC = WS_CTL + 512 * 1024;
constexpr size_t WS_Q = WS_Z, WS_IDX = WS_Z + 144 * MiB, WS_GATE = WS_Z + 162 * MiB;
static_assert(WS_Z + (size_t)NTOK * DINP * 2 <= WS_END, "ws map");
static_assert(WS_GATE + (size_t)NTOK * 128 * 4 <= WS_END, "ws map");

typedef __bf16 bf16x2_t __attribute__((ext_vector_type(2)));
__device__ __forceinline__ unsigned pk2(float lo, float hi) { const bf16x2_t v = __builtin_convertvector((f32x2){lo, hi}, bf16x2_t); return __builtin_bit_cast(unsigned, v); }
__device__ __forceinline__ unsigned f2bf(float f) { return pk2(f, 0.f) & 0xffffu; }
__device__ __forceinline__ float bflo(unsigned w) { return __builtin_bit_cast(float, w << 16); }
__device__ __forceinline__ float bfhi(unsigned w) { return __builtin_bit_cast(float, w & 0xffff0000u); }
__device__ __forceinline__ float bf2f(bf16_t h) { return __builtin_bit_cast(float, (unsigned)h << 16); }
__device__ __forceinline__ void unpack8(const u32x4 w, float (&f)[8]) { f[0] = bflo(w.x); f[1] = bfhi(w.x); f[2] = bflo(w.y); f[3] = bfhi(w.y); f[4] = bflo(w.z); f[5] = bfhi(w.z); f[6] = bflo(w.w); f[7] = bfhi(w.w); }
__device__ __forceinline__ float wave_sum(float v) {
#pragma unroll
    for (int o = 1; o < 64; o <<= 1) v += __shfl_xor(v, o);
    return v;
}
template <int CTRL> __device__ __forceinline__ float dppf(float x) { return __builtin_bit_cast(float, __builtin_amdgcn_mov_dpp(__builtin_bit_cast(int, x), CTRL, 0xf, 0xf, true)); }
constexpr int XOR1 = 0xB1, XOR2 = 0x4E, XOR7 = 0x141, ROR8 = 0x128;
__device__ __forceinline__ float sum8(float v) { v += dppf<XOR1>(v); v += dppf<XOR2>(v); v += dppf<XOR7>(v); return v; }
__device__ __forceinline__ float sum16(float v) { v = sum8(v); v += dppf<ROR8>(v); return v; }
__device__ __forceinline__ float sigmoidf_(float x) { return 1.0f / (1.0f + __expf(-x)); }
__device__ __forceinline__ float tanhf_(float x) { const float e = __expf(-2.0f * fabsf(x)); const float t = (1.0f - e) / (1.0f + e); return x < 0.f ? -t : t; }
__device__ __forceinline__ float gelu_tanh(float x) { const float u = 0.7978845608028654f * (x + 0.044715f * x * x * x); return 0.5f * x * (1.0f + tanhf_(u)); }

namespace pg8 {
constexpr int BM = 256, BK = 64, HALF = 128, HTB = HALF * BK * 2, STAGE_BYTES = 8 * HTB, NXCD = 8, WGM = 8;
__host__ __device__ __forceinline__ int lds_byte(int r, int c) { const int st = (r >> 4) * 2 + (c >> 5), rr = r & 15, cc = c & 31, ob = rr * 64 + cc * 2; return st * 1024 + (ob ^ (((ob >> 9) & 1) << 5)); }
__host__ __device__ __forceinline__ void stage_rc(int b, int& R, int& C) { const int st = b / 1024, sb = b % 1024, swz = sb ^ (((sb >> 9) & 1) << 5); R = (st >> 1) * 16 + swz / 64; C = (st & 1) * 32 + (swz % 64) / 2; }
__host__ __device__ __forceinline__ int perm32(int rho) { const int n = rho >> 4, i = rho & 15; return 8 * (i >> 2) + 4 * n + (i & 3); }
struct Unit { int pm, pn; };
struct Gemm { const bf16_t* A; const bf16_t* Bt; int lda, K, acs; };
struct StaticOrder {
    int nM, nN, nwg, G, c;
    __device__ __forceinline__ void init(int nM_, int nN_, int G_, int c_) { nM = nM_; nN = nN_; nwg = nM * nN; G = G_; c = c_; }
    __device__ __forceinline__ bool next(int i, Unit& u) const {
        const long L = (long)i * G + c; if (L >= nwg) return false;
        int wgid = (int)L; { const int q = nwg / NXCD, r = nwg % NXCD, xcd = wgid % NXCD, off = wgid / NXCD; wgid = (xcd < r ? xcd * (q + 1) : r * (q + 1) + (xcd - r) * q) + off; }
        const int nig = WGM * nN, gid = wgid / nig, fm = gid * WGM, gsz = (nM - fm) < WGM ? (nM - fm) : WGM;
        u.pm = fm + ((wgid % nig) % gsz); u.pn = (wgid % nig) / gsz; return true;
    }
};
struct OneUnit { Unit u; __device__ __forceinline__ bool next(int i, Unit& o) const { if (i != 0) return false; o = u; return true; } };

__device__ __forceinline__ unsigned cvt_pk_bf16(float lo, float hi) { unsigned r; asm volatile("v_cvt_pk_bf16_f32 %0, %1, %2" : "=v"(r) : "v"(lo), "v"(hi)); return r; }

struct EpiBf16 {
    static constexpr bool PERM = true, AFTER_DRAIN = false;
    bf16_t* O; int ldc;
    __device__ __forceinline__ void operator()(const f32x4 (&acc)[2][2][4][2], const Unit& u, int wr, int wc, int fr, int fq) const {
        const int row0 = u.pm * BM + wr * 64 + fr; const int col0 = u.pn * BM + wc * 32 + 8 * fq;
#pragma unroll
        for (int ai = 0; ai < 2; ++ai)
#pragma unroll
            for (int m = 0; m < 4; ++m) { bf16_t* rowp = O + (size_t)(row0 + ai * HALF + m * 16) * ldc + col0;
#pragma unroll
                for (int bj = 0; bj < 2; ++bj) { const f32x4 v0 = acc[ai][bj][m][0], v1 = acc[ai][bj][m][1];
                    u32x4 w; w.x = cvt_pk_bf16(v0[0], v0[1]); w.y = cvt_pk_bf16(v0[2], v0[3]); w.z = cvt_pk_bf16(v1[0], v1[1]); w.w = cvt_pk_bf16(v1[2], v1[3]);
                    *(u32x4*)(rowp + bj * HALF) = w; } }
    }
};
template <bool BASE_BF16> struct EpiRes {
    static constexpr bool PERM = true, AFTER_DRAIN = false;
    const float* base_l; const float* base_c; bf16_t* XR; const float* gate; float oscale;
    __device__ __forceinline__ void operator()(const f32x4 (&acc)[2][2][4][2], const Unit& u, int wr, int wc, int fr, int fq) const {
        const int rowt = u.pm * BM; const bool isc = rowt >= NLAT;
        const int mrow = isc ? 16 : rowt / SEQ;
        const float* base = isc ? base_c - (size_t)NLAT * D : base_l;
        const int row0 = rowt + wr * 64 + fr, col0 = u.pn * BM + wc * 32 + 8 * fq;
        f32x4 gv[2][2];
#pragma unroll
        for (int bj = 0; bj < 2; ++bj)
#pragma unroll
            for (int n = 0; n < 2; ++n) gv[bj][n] = *(const f32x4*)(gate + (size_t)mrow * 6144 + col0 + bj * HALF + n * 4) * oscale;
#pragma unroll
        for (int ai = 0; ai < 2; ++ai)
#pragma unroll
            for (int m = 0; m < 4; ++m) { const size_t off = (size_t)(row0 + ai * HALF + m * 16) * D + col0;
#pragma unroll
                for (int bj = 0; bj < 2; ++bj) { f32x4 b0, b1;
                    if (BASE_BF16) { const u32x4 w = *(const u32x4*)(XR + off + bj * HALF); b0 = (f32x4){bflo(w.x), bfhi(w.x), bflo(w.y), bfhi(w.y)}; b1 = (f32x4){bflo(w.z), bfhi(w.z), bflo(w.w), bfhi(w.w)}; }
                    else { b0 = *(const f32x4*)(base + off + bj * HALF); b1 = *(const f32x4*)(base + off + bj * HALF + 4); }
                    const f32x4 x0 = b0 + gv[bj][0] * acc[ai][bj][m][0], x1 = b1 + gv[bj][1] * acc[ai][bj][m][1];
                    *(u32x4*)(XR + off + bj * HALF) = (u32x4){pk2(x0[0], x0[1]), pk2(x0[2], x0[3]), pk2(x1[0], x1[1]), pk2(x1[2], x1[3])}; }
                asm volatile("" ::: "memory"); }
    }
};

template <class Epi, class Sched, bool ALIGN_EPI = false>
__device__ __forceinline__ void gemm_phase(LAS unsigned char* lds, const Gemm g, const Sched& S, const Epi& E) {
    int tid = threadIdx.x; asm volatile("" : "+v"(tid));
    const int wid = __builtin_amdgcn_readfirstlane(tid >> 6), lane = tid & 63, wr = wid >> 2, wc = wid & 3, fr = lane & 15, fq = lane >> 4;
    const int K = g.K, nt = K / BK;
    unsigned voffA[2], voffB[2];
#pragma unroll
    for (int i = 0; i < 2; ++i) { int R, C; stage_rc(tid * 16 + i * 8192, R, C); const int Rb = Epi::PERM ? ((R & ~31) + perm32(R & 31)) : R;
        voffA[i] = (unsigned)(R * g.lda + C) * 2u; voffB[i] = (unsigned)(Rb * K + C) * 2u; }
    const size_t kstep = (size_t)(BK * 2);
    const size_t hA = (size_t)HALF * g.lda * 2, hB = (size_t)HALF * K * 2;
    const size_t tA = 2 * hA, tB = 2 * hB;
    const unsigned ldsw = (unsigned)wid * 1024u;
    const int aoff = lds_byte(wr * 64 + fr, fq * 8), boff = lds_byte(wc * 32 + fr, fq * 8);
#define PG8_SA(b, h) (((b) * 2 + (h)) * HTB)
#define PG8_SB(b, h) ((4 + (b) * 2 + (h)) * HTB)
#define PG8_STAGE(bufoff, gbase, voff) do { _Pragma("unroll") for (int _i = 0; _i < 2; ++_i) { unsigned _vo = (voff)[_i]; asm volatile("" : "+v"(_vo)); \
        __builtin_amdgcn_global_load_lds((const unsigned*)((const char*)(gbase) + _vo), (LAS unsigned*)(lds + (bufoff) + ldsw + _i * 8192), 16, 0, 0); } } while (0)
#define PG8_LDA(dst, b, h) do { _Pragma("unroll") for (int m = 0; m < 4; ++m) _Pragma("unroll") for (int k = 0; k < 2; ++k) dst[m][k] = *(const LAS bf16x8*)(lds + PG8_SA(b, h) + aoff + m * 2048 + k * 1024); } while (0)
#define PG8_LDB(dst, b, h) do { _Pragma("unroll") for (int n = 0; n < 2; ++n) _Pragma("unroll") for (int k = 0; k < 2; ++k) dst[n][k] = *(const LAS bf16x8*)(lds + PG8_SB(b, h) + boff + n * 2048 + k * 1024); } while (0)
#define PG8_MMA(ai, bj, At, Bt) do { __builtin_amdgcn_s_setprio(1); _Pragma("unroll") for (int m = 0; m < 4; ++m) _Pragma("unroll") for (int n = 0; n < 2; ++n) _Pragma("unroll") for (int k = 0; k < 2; ++k) \
        acc[ai][bj][m][n] = __builtin_amdgcn_mfma_f32_16x16x32_bf16(Bt[n][k], At[m][k], acc[ai][bj][m][n], 0, 0, 0); __builtin_amdgcn_s_setprio(0); } while (0)
#define PG8_WAIT_V(n) asm volatile("s_waitcnt vmcnt(" #n ")" ::: "memory")
#define PG8_WAIT_L(n) asm volatile("s_waitcnt lgkmcnt(" #n ")" ::: "memory")
#define PG8_BAR __builtin_amdgcn_s_barrier()
#define PG8_SCHED __builtin_amdgcn_sched_barrier(0)
    Unit cur, nxt; int ui = 0;
    if (!S.next(0, cur)) return;
    f32x4 acc[2][2][4][2];
#pragma unroll
    for (int a = 0; a < 2; ++a)
#pragma unroll
        for (int b = 0; b < 2; ++b)
#pragma unroll
            for (int m = 0; m < 4; ++m)
#pragma unroll
                for (int n = 0; n < 2; ++n) acc[a][b][m][n] = (f32x4){0.f, 0.f, 0.f, 0.f};
    bf16x8 At[4][2], B0[2][2], B1[2][2];
    const char* cA = (const char*)g.A + (size_t)cur.pm * tA + (size_t)cur.pn * g.acs * 2; const char* cB = (const char*)g.Bt + (size_t)cur.pn * tB;
    PG8_STAGE(PG8_SB(0, 0), cB, voffB); PG8_STAGE(PG8_SB(0, 1), cB + hB, voffB); PG8_STAGE(PG8_SA(0, 0), cA, voffA); PG8_STAGE(PG8_SA(0, 1), cA + hA, voffA);
    if (wr == 1) PG8_BAR;
    PG8_WAIT_V(2); PG8_BAR;
    PG8_STAGE(PG8_SB(1, 0), cB + kstep, voffB); PG8_STAGE(PG8_SA(1, 0), cA + kstep, voffA); PG8_STAGE(PG8_SB(1, 1), cB + hB + kstep, voffB);
    PG8_WAIT_V(6); PG8_BAR;
    for (;;) {
        const bool has_next = S.next(ui + 1, nxt);
        const char* nA = has_next ? (const char*)g.A + (size_t)nxt.pm * tA + (size_t)nxt.pn * g.acs * 2 : cA; const char* nB = has_next ? (const char*)g.Bt + (size_t)nxt.pn * tB : cB;
        for (int t = 0; t < nt; t += 2) {
            const bool last = (t == nt - 2);
            const char* a1 = cA + (size_t)(t + 1) * kstep;
            const char* a2 = last ? nA : cA + (size_t)(t + 2) * kstep; const char* b2 = last ? nB : cB + (size_t)(t + 2) * kstep;
            const char* a3 = a2 + kstep; const char* b3 = b2 + kstep;
            PG8_LDB(B0, 0, 0); PG8_LDB(B1, 0, 1); PG8_SCHED; PG8_LDA(At, 0, 0); PG8_STAGE(PG8_SA(1, 1), a1 + hA, voffA);
            PG8_WAIT_V(8); PG8_WAIT_L(0); PG8_BAR; PG8_MMA(0, 0, At, B0); PG8_MMA(0, 1, At, B1); PG8_BAR; PG8_SCHED;
            PG8_LDA(At, 0, 1); PG8_STAGE(PG8_SB(0, 0), b2, voffB); PG8_STAGE(PG8_SB(0, 1), b2 + hB, voffB); PG8_STAGE(PG8_SA(0, 0), a2, voffA);
            PG8_WAIT_V(8); PG8_WAIT_L(0); PG8_BAR; PG8_MMA(1, 0, At, B0); PG8_MMA(1, 1, At, B1); PG8_BAR; PG8_SCHED;
            PG8_LDB(B0, 1, 0); PG8_LDB(B1, 1, 1); PG8_SCHED; PG8_LDA(At, 1, 0); PG8_STAGE(PG8_SA(0, 1), a2 + hA, voffA);
            PG8_WAIT_V(8); PG8_WAIT_L(0); PG8_BAR; PG8_MMA(0, 0, At, B0); PG8_MMA(0, 1, At, B1); PG8_BAR; PG8_SCHED;
            PG8_LDA(At, 1, 1); PG8_STAGE(PG8_SB(1, 0), b3, voffB); PG8_STAGE(PG8_SB(1, 1), b3 + hB, voffB); PG8_STAGE(PG8_SA(1, 0), a3, voffA);
            PG8_WAIT_V(8); PG8_WAIT_L(0); PG8_BAR; PG8_MMA(1, 0, At, B0); PG8_MMA(1, 1, At, B1); PG8_BAR; PG8_SCHED;
        }
        if constexpr (ALIGN_EPI) { if (wr == 0) PG8_BAR; }
        if constexpr (!Epi::AFTER_DRAIN) { E(acc, cur, wr, wc, fr, fq); }
        if (!has_next) break;
#pragma unroll
        for (int a = 0; a < 2; ++a)
#pragma unroll
            for (int b = 0; b < 2; ++b)
#pragma unroll
                for (int m = 0; m < 4; ++m)
#pragma unroll
                    for (int n = 0; n < 2; ++n) acc[a][b][m][n] = (f32x4){0.f, 0.f, 0.f, 0.f};
        cur = nxt; cA = nA; cB = nB; ++ui;
        if constexpr (ALIGN_EPI) { if (wr == 1) PG8_BAR; }
    }
    PG8_WAIT_V(0);
    if constexpr (!ALIGN_EPI) { if (wr == 0) PG8_BAR; }
    PG8_BAR;
    if constexpr (Epi::AFTER_DRAIN) { E.fused(acc, cur, wr, wc, fr, fq, lds, wid, lane); }
#undef PG8_SA
#undef PG8_SB
#undef PG8_STAGE
#undef PG8_LDA
#undef PG8_LDB
#undef PG8_MMA
#undef PG8_WAIT_V
#undef PG8_WAIT_L
#undef PG8_BAR
#undef PG8_SCHED
}
}
struct Args { const float* in[26]; float* out; unsigned char* ws; int pad0, pad1; };
typedef const float* fptr_t;
typedef const __attribute__((address_space(4))) fptr_t* ktab_t;
struct Frame {
    LAS unsigned char* lds;
    int tid, lane, wave, G, bid;
    ktab_t tab;
};
#define FWS(F) ((unsigned char*)(F).tab[27])
#define FOUT(F) ((float*)(F).tab[26])

#define XB_TMO      128
#define XB_XCNT(j)  (256  + 64 * (j))
#define XB_XSUB(j)  (1280 + 64 * (j))
#define XB_XGEN(j)  (2304 + 64 * (j))
#define XB_TOP      3328
#define XB_TOPGEN   3392
#define XCD_BAR_WORDS 3456
#define XB_SPIN_CAP (1u << 22)
__device__ __forceinline__ unsigned xb_ld(unsigned* p)              { return __hip_atomic_load(p, __ATOMIC_RELAXED, __HIP_MEMORY_SCOPE_AGENT); }
__device__ __forceinline__ unsigned xb_add(unsigned* p, unsigned v) { return __hip_atomic_fetch_add(p, v, __ATOMIC_RELAXED, __HIP_MEMORY_SCOPE_AGENT); }
__device__ __forceinline__ unsigned xb_xcc_id() { return (unsigned)__builtin_amdgcn_s_getreg((3 << 11) | 20) & 0xFu; }
#define XB_SPIN(cond, bar) do { unsigned _sp = 0; while (cond) { __builtin_amdgcn_s_sleep(1); \
    if ((++_sp & 255u) == 0u) { if (xb_ld(&(bar)[XB_TMO])) break; if (_sp > XB_SPIN_CAP) { atomicAdd(&(bar)[XB_TMO], 1u); break; } } } } while (0)
struct XcdBarrier { unsigned* bar; unsigned x; volatile LAS unsigned* st; };
__device__ __forceinline__ XcdBarrier xcd_barrier_post(unsigned* bar, volatile LAS unsigned* st) {
    XcdBarrier b; b.bar = bar; b.x = xb_xcc_id(); b.st = st;
    if (threadIdx.x == 0) (void)xb_add(&bar[XB_XCNT(b.x)], 1u);
    return b;
}
__device__ __forceinline__ void xcd_barrier_complete(unsigned* bar, unsigned x, unsigned& nloc, unsigned& nx) {
    const unsigned G = gridDim.x * gridDim.y * gridDim.z;
    unsigned sum, cnt, mine, sp = 0u;
    for (;;) {
        sum = 0u; cnt = 0u; mine = 0u;
#pragma unroll
        for (unsigned j = 0; j < 16; ++j) { const unsigned c = xb_ld(&bar[XB_XCNT(j)]); sum += c; cnt += (c > 0u) ? 1u : 0u; mine = (j == x) ? c : mine; }
        if (sum == G) break;
        __builtin_amdgcn_s_sleep(1);
        if ((++sp & 255u) == 0u) { if (xb_ld(&bar[XB_TMO])) break; if (sp > XB_SPIN_CAP) { atomicAdd(&bar[XB_TMO], 1u); break; } }
    }
    nloc = mine > 0u ? mine : 1u; nx = cnt > 0u ? cnt : 1u;
}
__device__ __forceinline__ void xcd_barrier(const XcdBarrier& b) {
    asm volatile("s_waitcnt vmcnt(0)" ::: "memory");
    __syncthreads();
    if (threadIdx.x == 0) {
        unsigned* bar = b.bar;
        __builtin_amdgcn_s_waitcnt(0);
        unsigned nloc = b.st[0], nx = b.st[1];
        if (nloc == 0u) { xcd_barrier_complete(bar, b.x, nloc, nx); b.st[0] = nloc; b.st[1] = nx; }
        const unsigned old = xb_add(&bar[XB_XSUB(b.x)], 1u);
        const unsigned gen = old / nloc;
        if (old + 1u == (gen + 1u) * nloc) {
            __builtin_amdgcn_fence(__ATOMIC_RELEASE, "agent");
            asm volatile("s_waitcnt vmcnt(0)" ::: "memory");
            const unsigned og = xb_add(&bar[XB_TOP], 1u);
            const unsigned tg = og / nx;
            if (og + 1u == (tg + 1u) * nx) xb_add(&bar[XB_TOPGEN], 1u);
            else XB_SPIN(xb_ld(&bar[XB_TOPGEN]) == tg, bar);
            __builtin_amdgcn_fence(__ATOMIC_ACQUIRE, "agent");
            xb_add(&bar[XB_XGEN(b.x)], 1u);
            asm volatile("s_waitcnt vmcnt(0)" ::: "memory");
        } else {
            XB_SPIN(xb_ld(&bar[XB_XGEN(b.x)]) == gen, bar);
            __builtin_amdgcn_fence(__ATOMIC_ACQUIRE, "agent");
            asm volatile("s_waitcnt vmcnt(0)" ::: "memory");
        }
    }
    __syncthreads();
}

enum { I_X = 0, I_C, I_CTX, I_CCTX, I_ADAW, I_ADAB, I_N1G, I_N2G, I_WIN, I_RW0, I_RWUP, I_RA0, I_RAUP, I_RGUP, I_RKK, I_RKA, I_RRK, I_RLNX, I_RPB, I_SCW, I_WOUT, I_PQW, I_PSK, I_PU, I_PV, I_FING };

__device__ __forceinline__ void p0_transpose_item(const float* W, int K, int N, bf16_t* WT, LAS float* scr, int item, int lane) {
    const int nblk = N / 32, kb = item / nblk, nb = item % nblk, k0 = 64 * kb, n0 = 32 * nb;
#pragma unroll 8
    for (int i = 0; i < 32; ++i) { const int kk = 2 * i + (lane >> 5); scr[kk * 33 + (lane & 31)] = W[(size_t)(k0 + kk) * N + n0 + (lane & 31)]; }
    asm volatile("s_waitcnt lgkmcnt(0)" ::: "memory");
    const int c = lane & 7;
#pragma unroll
    for (int j = 0; j < 4; ++j) { const int n = (lane >> 3) + 8 * j; const LAS float* s = scr + (8 * c) * 33 + n;
        u32x4 o; o.x = pk2(s[0 * 33], s[1 * 33]); o.y = pk2(s[2 * 33], s[3 * 33]); o.z = pk2(s[4 * 33], s[5 * 33]); o.w = pk2(s[6 * 33], s[7 * 33]);
        *(u32x4*)(WT + (size_t)(n0 + n) * K + k0 + 8 * c) = o; }
    asm volatile("s_waitcnt lgkmcnt(0)" ::: "memory");
}

__device__ __forceinline__ void cvt_stream(Frame& F, const float* src, bf16_t* dst, size_t n) {
    const size_t nv = n / 8; const size_t gt = (size_t)F.bid * NTHR + F.tid, GT = (size_t)F.G * NTHR;
    for (size_t i = gt; i < nv; i += GT) {
        const f32x4 a = *(const f32x4*)(src + i * 8), b = *(const f32x4*)(src + i * 8 + 4);
        u32x4 o; o.x = pk2(a[0], a[1]); o.y = pk2(a[2], a[3]); o.z = pk2(b[0], b[1]); o.w = pk2(b[2], b[3]);
        *(u32x4*)(dst + i * 8) = o;
    }
}

__device__ __forceinline__ float wave_max(float v) {
    v = fmaxf(v, dppf<XOR1>(v)); v = fmaxf(v, dppf<XOR2>(v)); v = fmaxf(v, dppf<XOR7>(v)); v = fmaxf(v, dppf<ROR8>(v));
    v = fmaxf(v, __shfl_xor(v, 16)); v = fmaxf(v, __shfl_xor(v, 32)); return v;
}
__device__ __forceinline__ void convert_peer_tables(Frame& F) {
    const int gw = F.bid * NWAVES + F.wave, NGW = F.G * NWAVES, lane = F.lane;
    for (int g4 = gw; g4 < PN; g4 += NGW) {
        const int r0 = 4 * g4, tb = r0 / PN, e0 = r0 % PN, layer = tb >> 1;
        const float* src = ((tb & 1) ? F.tab[I_PV] : F.tab[I_PU]) + ((size_t)layer * PN + e0) * D + 16 * lane;
        f32x4 v[4][4];
#pragma unroll
        for (int rr = 0; rr < 4; ++rr)
#pragma unroll
            for (int j = 0; j < 4; ++j) v[rr][j] = *(const f32x4*)(src + (size_t)rr * D + 4 * j);
#pragma unroll
        for (int rr = 0; rr < 4; ++rr) {
            float mx = 0.f;
#pragma unroll
            for (int j = 0; j < 4; ++j) mx = fmaxf(mx, fmaxf(fmaxf(fabsf(v[rr][j][0]), fabsf(v[rr][j][1])), fmaxf(fabsf(v[rr][j][2]), fabsf(v[rr][j][3]))));
            mx = wave_max(mx);
            const float sc = mx > 0.f ? mx * (1.0f / 6.0f) : 1.0f, inv = 1.0f / sc;
            unsigned w0 = 0u, w1 = 0u;
            w0 = __builtin_amdgcn_cvt_scalef32_pk_fp4_f32(w0, v[rr][0][0] * inv, v[rr][0][1] * inv, 1.0f, 0); w0 = __builtin_amdgcn_cvt_scalef32_pk_fp4_f32(w0, v[rr][0][2] * inv, v[rr][0][3] * inv, 1.0f, 1);
            w0 = __builtin_amdgcn_cvt_scalef32_pk_fp4_f32(w0, v[rr][1][0] * inv, v[rr][1][1] * inv, 1.0f, 2); w0 = __builtin_amdgcn_cvt_scalef32_pk_fp4_f32(w0, v[rr][1][2] * inv, v[rr][1][3] * inv, 1.0f, 3);
            w1 = __builtin_amdgcn_cvt_scalef32_pk_fp4_f32(w1, v[rr][2][0] * inv, v[rr][2][1] * inv, 1.0f, 0); w1 = __builtin_amdgcn_cvt_scalef32_pk_fp4_f32(w1, v[rr][2][2] * inv, v[rr][2][3] * inv, 1.0f, 1);
            w1 = __builtin_amdgcn_cvt_scalef32_pk_fp4_f32(w1, v[rr][3][0] * inv, v[rr][3][1] * inv, 1.0f, 2); w1 = __builtin_amdgcn_cvt_scalef32_pk_fp4_f32(w1, v[rr][3][2] * inv, v[rr][3][3] * inv, 1.0f, 3);
            *(u32x2*)(FWS(F) + WS_PU + (size_t)layer * (16 * MiB) + (size_t)(e0 + rr) * 1024 + (tb & 1) * 512 + 8 * lane) = (u32x2){w0, w1};
            if (lane == 0) ((float*)(FWS(F) + WS_PSC))[((size_t)layer * PN + e0 + rr) * 2 + (tb & 1)] = sc;
        }
    }
}

__device__ __forceinline__ void p0_prologue(Frame& F) {
    {
        LAS float* scr = (LAS float*)(F.lds + F.wave * 16384);
        const int gw = F.bid * NWAVES + F.wave, NGW = F.G * NWAVES;
        constexpr int I_IN = (D / 64) * (DIN / 32), I_OUT = (D / 64) * (D / 32);
        constexpr int PER_L = I_IN + I_OUT;
        for (int it = gw; it < 2 * PER_L; it += NGW) {
            const int l = it / PER_L; int r = it % PER_L;
            if (r < I_IN) { p0_transpose_item(F.tab[I_WIN] + (size_t)l * D * DIN, D, DIN, (bf16_t*)(FWS(F) + WS_WIN) + (size_t)l * DINP * D, scr, r, F.lane); continue; } r -= I_IN;
            p0_transpose_item(F.tab[I_WOUT] + (size_t)l * D * D, D, D, (bf16_t*)(FWS(F) + WS_WOUT) + (size_t)l * D * D, scr, r, F.lane);
        }
        {
            const int fr = F.lane & 15, fg = F.lane >> 4;
            for (int it = gw; it < 2 * 16 * 8 * 64; it += NGW) {
                const int kt = it & 63, nt = (it >> 6) & 7, hp = (it >> 9) & 15, l = it >> 13;
                const float* Ap = F.tab[I_PSK] + (((size_t)l * 16 + hp) * 128 + 16 * nt + fr) * 128 + 8 * fg;
                const float* Bp = F.tab[I_PQW] + ((size_t)l * D + 16 * kt + fr) * 2048 + hp * 128 + 8 * fg;
                f32x4 acc = (f32x4){0.f, 0.f, 0.f, 0.f};
#pragma unroll
                for (int ks = 0; ks < 4; ++ks) {
                    const f32x4 a0 = *(const f32x4*)(Ap + 32 * ks), a1 = *(const f32x4*)(Ap + 32 * ks + 4), b0 = *(const f32x4*)(Bp + 32 * ks), b1 = *(const f32x4*)(Bp + 32 * ks + 4);
                    const u32x4 av = (u32x4){pk2(a0[0], a0[1]), pk2(a0[2], a0[3]), pk2(a1[0], a1[1]), pk2(a1[2], a1[3])}, bv = (u32x4){pk2(b0[0], b0[1]), pk2(b0[2], b0[3]), pk2(b1[0], b1[1]), pk2(b1[2], b1[3])};
                    acc = __builtin_amdgcn_mfma_f32_16x16x32_bf16(__builtin_bit_cast(bf16x8, av), __builtin_bit_cast(bf16x8, bv), acc, 0, 0, 0);
                }
                bf16_t* o = (bf16_t*)(FWS(F) + WS_QW) + ((size_t)l * 2048 + hp * 128 + 16 * nt + 4 * fg) * D + 16 * kt + fr;
#pragma unroll
                for (int rg = 0; rg < 4; ++rg) o[(size_t)rg * D] = (bf16_t)f2bf(acc[rg]);
            }
        }
    }
    const size_t gt = (size_t)F.bid * NTHR + F.tid, GT = (size_t)F.G * NTHR;
    for (size_t i = gt; i < (size_t)2 * 128 * D / 8; i += GT) { const size_t l = i / (128 * D / 8), r = i % (128 * D / 8);
        *(u32x4*)((bf16_t*)(FWS(F) + WS_WIN) + (l * DINP + DIN) * D + r * 8) = (u32x4){0u, 0u, 0u, 0u}; }
    for (size_t i = gt; i < (size_t)2 * 2 * 256 * 64; i += GT) {
        const int r = (int)(i & 63), c = (int)((i >> 6) & 255); const size_t ld = i >> 14;
        ((bf16_t*)(FWS(F) + WS_WUPT))[i] = (bf16_t)f2bf(F.tab[I_RWUP][(ld * 64 + r) * 256 + c]);
        ((bf16_t*)(FWS(F) + WS_AUPT))[i] = (bf16_t)f2bf(F.tab[I_RAUP][(ld * 64 + r) * 256 + c]);
    }
    convert_peer_tables(F);
    {
        __syncthreads();
        LAS float* sv = (LAS float*)F.lds;
        LAS float* red = (LAS float*)(F.lds + 17 * 1024 * 4);
        if (F.bid < 384) {
#pragma unroll
            for (int hb = 0; hb < 2; ++hb) { float xv[17];
#pragma unroll
                for (int it = 0; it < 17; ++it) { const int i = F.tid + NTHR * (17 * hb + it); xv[it] = (i < 16 * 1024) ? F.tab[I_C][i] : F.tab[I_CCTX][i - 16 * 1024]; }
#pragma unroll
                for (int it = 0; it < 17; ++it) { const int i = F.tid + NTHR * (17 * hb + it); sv[i] = xv[it] * sigmoidf_(xv[it]); } }
        }
        __syncthreads();
        for (int it = F.bid; it < 384; it += F.G) {
            const int l = it / 192, n0 = (it % 192) * 32;
            const int kg = F.tid >> 3, cq = F.tid & 7;
            float acc[17][4];
#pragma unroll
            for (int r = 0; r < 17; ++r) { acc[r][0] = 0.f; acc[r][1] = 0.f; acc[r][2] = 0.f; acc[r][3] = 0.f; }
            const float* W = F.tab[I_ADAW] + (size_t)l * D * 6144 + n0 + 4 * cq;
#pragma nounroll
            for (int hb = 0; hb < 2; ++hb) {
                f32x4 wv[8];
#pragma unroll
                for (int i = 0; i < 8; ++i) wv[i] = *(const f32x4*)(W + (size_t)(kg + 64 * (8 * hb + i)) * 6144);
#pragma unroll
                for (int i = 0; i < 8; ++i) { const f32x4 w = wv[i]; const int k = kg + 64 * (8 * hb + i);
#pragma unroll
                    for (int r = 0; r < 17; ++r) { const float s = sv[r * 1024 + k]; acc[r][0] += s * w[0]; acc[r][1] += s * w[1]; acc[r][2] += s * w[2]; acc[r][3] += s * w[3]; }
                }
            }
#pragma unroll
            for (int r = 0; r < 17; ++r)
#pragma unroll
                for (int j = 0; j < 4; ++j) { float v = acc[r][j]; v += __shfl_xor(v, 8); v += __shfl_xor(v, 16); v += __shfl_xor(v, 32); acc[r][j] = v; }
            if (F.lane < 8) {
#pragma unroll
                for (int r = 0; r < 17; ++r)
#pragma unroll
                    for (int j = 0; j < 4; ++j) red[(F.wave * 17 + r) * 32 + 4 * cq + j] = acc[r][j];
            }
            __syncthreads();
            for (int i = F.tid; i < 17 * 32; i += NTHR) { float s = 0.f;
#pragma unroll
                for (int w = 0; w < 8; ++w) s += red[w * 17 * 32 + i];
                const int r = i / 32, n = n0 + (i & 31);
                ((float*)(FWS(F) + WS_MOD))[((size_t)l * 17 + r) * 6144 + n] = s + F.tab[I_ADAB][(size_t)l * 6144 + n]; }
            __syncthreads();
        }
    }
}

__device__ __forceinline__ void norm_mod_finish(const f32x4 (&v)[4], float s, const float* g, const float* modrow_sh, bf16_t* orow, int lane) {
    const float rs = rsqrtf(wave_sum(s) * (1.f / D) + 1e-6f);
    u32x2* o8 = (u32x2*)orow + lane;
#pragma unroll
    for (int j = 0; j < 4; ++j) {
        const f32x4 gg = ((const f32x4*)g + lane)[64 * j], sh = ((const f32x4*)modrow_sh + lane)[64 * j], sc = ((const f32x4*)(modrow_sh + 1024) + lane)[64 * j];
        const f32x4 y = v[j] * rs * gg * (sc + 1.0f) + sh;
        u32x2 w; w.x = pk2(y[0], y[1]); w.y = pk2(y[2], y[3]); o8[64 * j] = w;
    }
}
__device__ __forceinline__ void norm_mod_phase(Frame& F, const float* xl, const float* xc, const float* g, const float* mod, int shoff, int nrows) {
    const int gw = F.bid * NWAVES + F.wave, NGW = F.G * NWAVES, lane = F.lane;
    bf16_t* H = (bf16_t*)(FWS(F) + WS_H);
    const int per = (nrows + NGW - 1) / NGW;
    int m = gw * per; const int mend = m + per < nrows ? m + per : nrows;
    if (m >= mend) return;
    f32x4 pA[4], pS[4]; int cur = -1;
    f32x4 v[2][4], vn[2][4];
#pragma unroll
    for (int q = 0; q < 2; ++q) { const int r = m + q < mend ? m + q : m; const float* xr = (r >= NLAT) ? xc + (size_t)(r - NLAT) * D : xl + (size_t)r * D;
#pragma unroll
        for (int j = 0; j < 4; ++j) v[q][j] = ((const f32x4*)xr + lane)[64 * j]; }
    for (; m < mend; m += 2) {
#pragma unroll
        for (int q = 0; q < 2; ++q) { const int r = m + 2 + q < mend ? m + 2 + q : m; const float* xr = (r >= NLAT) ? xc + (size_t)(r - NLAT) * D : xl + (size_t)r * D;
#pragma unroll
            for (int j = 0; j < 4; ++j) vn[q][j] = ((const f32x4*)xr + lane)[64 * j]; }
#pragma unroll
        for (int q = 0; q < 2; ++q) {
            const int r = m + q; if (r >= mend) break;
            const int mrow = (r >= NLAT) ? 16 : r / SEQ;
            if (mrow != cur) { cur = mrow; const float* shp = mod + (size_t)mrow * 6144 + shoff;
#pragma unroll
                for (int j = 0; j < 4; ++j) { pA[j] = ((const f32x4*)g + lane)[64 * j] * (((const f32x4*)(shp + 1024) + lane)[64 * j] + 1.0f); pS[j] = ((const f32x4*)shp + lane)[64 * j]; } }
            float s = 0.f;
#pragma unroll
            for (int j = 0; j < 4; ++j) s += (v[q][j].x * v[q][j].x + v[q][j].y * v[q][j].y) + (v[q][j].z * v[q][j].z + v[q][j].w * v[q][j].w);
            const float rs = rsqrtf(wave_sum(s) * (1.f / D) + 1e-6f);
            u32x2* o8 = (u32x2*)(H + (size_t)r * D) + lane;
#pragma unroll
            for (int j = 0; j < 4; ++j) { const f32x4 y = v[q][j] * rs * pA[j] + pS[j]; u32x2 w; w.x = pk2(y[0], y[1]); w.y = pk2(y[2], y[3]); o8[64 * j] = w; }
        }
#pragma unroll
        for (int q = 0; q < 2; ++q)
#pragma unroll
            for (int j = 0; j < 4; ++j) v[q][j] = vn[q][j];
    }
}

__device__ __forceinline__ void norm_mod_phase_xr(Frame& F, const float* g, const float* mod, int shoff, int nrows) {
    const int gw = F.bid * NWAVES + F.wave, NGW = F.G * NWAVES, lane = F.lane;
    const bf16_t* XR = (const bf16_t*)(FWS(F) + WS_XR); bf16_t* H = (bf16_t*)(FWS(F) + WS_H);
    const int per = (nrows + NGW - 1) / NGW;
    int m = gw * per; const int mend = m + per < nrows ? m + per : nrows;
    if (m >= mend) return;
    f32x4 pA[4], pS[4]; int cur = -1;
    u32x4 w[2][2], wn[2][2];
#pragma unroll
    for (int q = 0; q < 2; ++q) { const int r = m + q < mend ? m + q : m; w[q][0] = *(const u32x4*)(XR + (size_t)r * D + 16 * lane); w[q][1] = *(const u32x4*)(XR + (size_t)r * D + 16 * lane + 8); }
    for (; m < mend; m += 2) {
#pragma unroll
        for (int q = 0; q < 2; ++q) { const int r = m + 2 + q < mend ? m + 2 + q : m; wn[q][0] = *(const u32x4*)(XR + (size_t)r * D + 16 * lane); wn[q][1] = *(const u32x4*)(XR + (size_t)r * D + 16 * lane + 8); }
#pragma unroll
        for (int q = 0; q < 2; ++q) {
            const int r = m + q; if (r >= mend) break;
            const int mrow = (r >= NLAT) ? 16 : r / SEQ;
            if (mrow != cur) { cur = mrow; const float* shp = mod + (size_t)mrow * 6144 + shoff + 16 * lane;
#pragma unroll
                for (int j4 = 0; j4 < 4; ++j4) { pA[j4] = *(const f32x4*)(g + 16 * lane + 4 * j4) * (*(const f32x4*)(shp + 1024 + 4 * j4) + 1.0f); pS[j4] = *(const f32x4*)(shp + 4 * j4); } }
            float x[16]; { float t[8]; unpack8(w[q][0], t);
#pragma unroll
                for (int j = 0; j < 8; ++j) x[j] = t[j];
                unpack8(w[q][1], t);
#pragma unroll
                for (int j = 0; j < 8; ++j) x[8 + j] = t[j]; }
            float s = 0.f;
#pragma unroll
            for (int j = 0; j < 16; ++j) s += x[j] * x[j];
            const float rs = rsqrtf(wave_sum(s) * (1.f / D) + 1e-6f);
            unsigned o[8];
#pragma unroll
            for (int j4 = 0; j4 < 4; ++j4) { const f32x4 y = (f32x4){x[4 * j4], x[4 * j4 + 1], x[4 * j4 + 2], x[4 * j4 + 3]} * rs * pA[j4] + pS[j4];
                o[2 * j4] = pk2(y[0], y[1]); o[2 * j4 + 1] = pk2(y[2], y[3]); }
            *(u32x4*)(H + (size_t)r * D + 16 * lane) = (u32x4){o[0], o[1], o[2], o[3]}; *(u32x4*)(H + (size_t)r * D + 16 * lane + 8) = (u32x4){o[4], o[5], o[6], o[7]};
        }
#pragma unroll
        for (int q = 0; q < 2; ++q) { w[q][0] = wn[q][0]; w[q][1] = wn[q][1]; }
    }
}

constexpr int SCH = 32;
__device__ __forceinline__ int scan_row(int b, int dir, int s) {
    return dir == 0 ? (s < CTXL ? NLAT + b * CTXL + s : b * SEQ + (s - CTXL)) : (s < CTXL ? NLAT + b * CTXL + (CTXL - 1 - s) : b * SEQ + (SEQ - 1 - (s - CTXL)));
}
struct ScanOps { f32x4 kk[2], w[2], b[2], kd[2], r[2]; float v; };
__device__ __forceinline__ float fsigmoid(float x) { return __builtin_amdgcn_rcpf(1.0f + __builtin_amdgcn_exp2f(-1.4426950408889634f * x)); }
__device__ __forceinline__ float ftanh(float x) { const float e = __builtin_amdgcn_exp2f(-2.8853900817779268f * fabsf(x)); const float t = (1.0f - e) * __builtin_amdgcn_rcpf(1.0f + e); return x < 0.f ? -t : t; }
__device__ __forceinline__ void scan_unit(Frame& F, int layer, int b, int h, int dir, int half) {
    const bf16_t* Z = (const bf16_t*)(FWS(F) + WS_Z);
    float* YS = (float*)(FWS(F) + WS_Z) + (size_t)dir * NTOK * RWW;
    LAS float* L0 = (LAS float*)F.lds;
    constexpr int BUFW = 7 * 2048;
    LAS float* YB0 = L0 + 2 * BUFW;
    const int tid = F.tid, lane = F.lane, wave = F.wave, fr = lane & 15, fg = lane >> 4;
    constexpr int NCH = (CTXL + SEQ) / SCH;
    if (wave < 4) {
        const int srow = tid >> 3, jq = tid & 7, si = 32 * half + srow;
        f32x4 S0 = (f32x4){0.f, 0.f, 0.f, 0.f}, S1 = (f32x4){0.f, 0.f, 0.f, 0.f};
        __syncthreads();
        for (int c = 0; c < NCH; ++c) {
            LAS float* Rl = L0 + (c & 1) * BUFW; LAS float* KKl = Rl + 2048; LAS float* Vl = Rl + 4096; LAS float* Wl = Rl + 6144; LAS float* Bl = Rl + 8192; LAS float* KDl = Rl + 10240;
            LAS float* YBl = YB0 + (c & 1) * 1024;
#define SCAN_LOAD(o, t) do { _Pragma("unroll") for (int _h = 0; _h < 2; ++_h) { \
        (o).kk[_h] = *(const LAS f32x4*)(KKl + (t) * 64 + 8 * jq + 4 * _h); (o).w[_h] = *(const LAS f32x4*)(Wl + (t) * 64 + 8 * jq + 4 * _h); (o).b[_h] = *(const LAS f32x4*)(Bl + (t) * 64 + 8 * jq + 4 * _h); \
        (o).kd[_h] = *(const LAS f32x4*)(KDl + (t) * 64 + 8 * jq + 4 * _h); (o).r[_h] = *(const LAS f32x4*)(Rl + (t) * 64 + 8 * jq + 4 * _h); } (o).v = Vl[(t) * 64 + si]; } while (0)
#define SCAN_STEP(o, t) do { \
        const f32x4 _pa = S0 * (o).kk[0] + S1 * (o).kk[1]; float sa = (_pa[0] + _pa[1]) + (_pa[2] + _pa[3]); sa = sum8(sa); \
        S0 = S0 * (o).w[0] + ((o).kd[0] * (o).v - (o).b[0] * sa); S1 = S1 * (o).w[1] + ((o).kd[1] * (o).v - (o).b[1] * sa); \
        const f32x4 _py = S0 * (o).r[0] + S1 * (o).r[1]; float y = (_py[0] + _py[1]) + (_py[2] + _py[3]); y = sum8(y); \
        if (jq == 0) YBl[(t) * 32 + srow] = y; } while (0)
            ScanOps oa, ob;
            SCAN_LOAD(oa, 0);
#pragma unroll 1
            for (int t = 0; t < SCH; t += 2) {
                SCAN_LOAD(ob, t + 1);
                SCAN_STEP(oa, t);
                if (t + 2 < SCH) SCAN_LOAD(oa, t + 2);
                SCAN_STEP(ob, t + 1);
            }
#undef SCAN_LOAD
#undef SCAN_STEP
            __syncthreads();
        }
    } else if (wave < 6) {
        const int pw = wave - 4;
        const bf16_t* WUP = (const bf16_t*)(FWS(F) + WS_WUPT) + ((size_t)(layer * 2 + dir) * 256 + 64 * h + fr) * 64 + 8 * fg;
        const bf16_t* AUP = (const bf16_t*)(FWS(F) + WS_AUPT) + ((size_t)(layer * 2 + dir) * 256 + 64 * h + fr) * 64 + 8 * fg;
        const float* W0P = F.tab[I_RW0] + (size_t)(layer * 2 + dir) * 256 + 64 * h + fr; const float* A0P = F.tab[I_RA0] + (size_t)(layer * 2 + dir) * 256 + 64 * h + fr;
        const int tl = lane >> 2, q16 = (lane & 3) * 16;
        const float* KKP = F.tab[I_RKK] + (size_t)layer * 256 + 64 * h + q16; const float* KAP = F.tab[I_RKA] + (size_t)layer * 256 + 64 * h + q16;
        u32x4 pw_[2], pa_[2], prr[2], pkk[2], pvv[2];
#define P_LOAD(cc) do { \
        { const size_t zr = (size_t)scan_row(b, dir, (cc) * SCH + 16 * pw + fr) * DINP + 64 * dir + 8 * fg; \
          pw_[0] = *(const u32x4*)(Z + zr + ZW); pw_[1] = *(const u32x4*)(Z + zr + ZW + 32); pa_[0] = *(const u32x4*)(Z + zr + ZA); pa_[1] = *(const u32x4*)(Z + zr + ZA + 32); } \
        { const size_t zr = (size_t)scan_row(b, dir, (cc) * SCH + 16 * pw + tl) * DINP + 64 * h + q16; \
          prr[0] = *(const u32x4*)(Z + zr + ZR); prr[1] = *(const u32x4*)(Z + zr + ZR + 8); pkk[0] = *(const u32x4*)(Z + zr + ZK); pkk[1] = *(const u32x4*)(Z + zr + ZK + 8); \
          pvv[0] = *(const u32x4*)(Z + zr + ZV); pvv[1] = *(const u32x4*)(Z + zr + ZV + 8); } } while (0)
#define P_COMPUTE(cc) do { \
        LAS float* Rl = L0 + ((cc) & 1) * BUFW; LAS float* KKl = Rl + 2048; LAS float* Vl = Rl + 4096; LAS float* Wl = Rl + 6144; LAS float* Bl = Rl + 8192; LAS float* KDl = Rl + 10240; LAS float* ATl = Rl + 12288; \
        { bf16x8 aw[2]; \
          _Pragma("unroll") for (int ks = 0; ks < 2; ++ks) { float f[8]; u32x4 o; unpack8(pw_[ks], f); \
              o.x = pk2(ftanh(f[0]), ftanh(f[1])); o.y = pk2(ftanh(f[2]), ftanh(f[3])); o.z = pk2(ftanh(f[4]), ftanh(f[5])); o.w = pk2(ftanh(f[6]), ftanh(f[7])); aw[ks] = __builtin_bit_cast(bf16x8, o); } \
          _Pragma("unroll") for (int ct = 0; ct < 4; ++ct) { \
              f32x4 accw = (f32x4){0.f, 0.f, 0.f, 0.f}, acca = (f32x4){0.f, 0.f, 0.f, 0.f}; const float w0c = W0P[16 * ct], a0c = A0P[16 * ct]; \
              accw = __builtin_amdgcn_mfma_f32_16x16x32_bf16(aw[0], *(const bf16x8*)(WUP + ct * 1024), accw, 0, 0, 0); accw = __builtin_amdgcn_mfma_f32_16x16x32_bf16(aw[1], *(const bf16x8*)(WUP + ct * 1024 + 32), accw, 0, 0, 0); \
              acca = __builtin_amdgcn_mfma_f32_16x16x32_bf16(__builtin_bit_cast(bf16x8, pa_[0]), *(const bf16x8*)(AUP + ct * 1024), acca, 0, 0, 0); acca = __builtin_amdgcn_mfma_f32_16x16x32_bf16(__builtin_bit_cast(bf16x8, pa_[1]), *(const bf16x8*)(AUP + ct * 1024 + 32), acca, 0, 0, 0); \
              _Pragma("unroll") for (int rg = 0; rg < 4; ++rg) { const int o_ = (16 * pw + 4 * fg + rg) * 64 + 16 * ct + fr; \
                  Wl[o_] = __builtin_amdgcn_exp2f(-0.8750387749589899f * fsigmoid(accw[rg] + w0c)); ATl[o_] = fsigmoid(acca[rg] + a0c); } } } \
        asm volatile("s_waitcnt lgkmcnt(0)" ::: "memory"); \
        { float rr[16], kk_[16], vv_[16]; \
          { float t_[8]; unpack8(prr[0], t_); _Pragma("unroll") for (int j = 0; j < 8; ++j) rr[j] = t_[j]; unpack8(prr[1], t_); _Pragma("unroll") for (int j = 0; j < 8; ++j) rr[8 + j] = t_[j]; \
            unpack8(pkk[0], t_); _Pragma("unroll") for (int j = 0; j < 8; ++j) kk_[j] = t_[j]; unpack8(pkk[1], t_); _Pragma("unroll") for (int j = 0; j < 8; ++j) kk_[8 + j] = t_[j]; \
            unpack8(pvv[0], t_); _Pragma("unroll") for (int j = 0; j < 8; ++j) vv_[j] = t_[j]; unpack8(pvv[1], t_); _Pragma("unroll") for (int j = 0; j < 8; ++j) vv_[8 + j] = t_[j]; } \
          float ss = 0.f; float qn[16]; \
          _Pragma("unroll") for (int j = 0; j < 16; ++j) { qn[j] = kk_[j] * KKP[j]; ss += qn[j] * qn[j]; } \
          ss += dppf<XOR1>(ss); ss += dppf<XOR2>(ss); \
          const float inv = rsqrtf(ss + 1e-12f); \
          const int o_ = (16 * pw + tl) * 64 + q16; \
          _Pragma("unroll") for (int j4 = 0; j4 < 4; ++j4) { \
              const f32x4 a_ = *(const LAS f32x4*)(ATl + o_ + 4 * j4); const f32x4 ka_ = *(const f32x4*)(KAP + 4 * j4); \
              const f32x4 kq = (f32x4){qn[4 * j4] * inv, qn[4 * j4 + 1] * inv, qn[4 * j4 + 2] * inv, qn[4 * j4 + 3] * inv}; \
              *(LAS f32x4*)(Rl + o_ + 4 * j4) = (f32x4){rr[4 * j4], rr[4 * j4 + 1], rr[4 * j4 + 2], rr[4 * j4 + 3]}; \
              *(LAS f32x4*)(KKl + o_ + 4 * j4) = kq; \
              *(LAS f32x4*)(Vl + o_ + 4 * j4) = (f32x4){vv_[4 * j4], vv_[4 * j4 + 1], vv_[4 * j4 + 2], vv_[4 * j4 + 3]}; \
              *(LAS f32x4*)(Bl + o_ + 4 * j4) = kq * a_; \
              *(LAS f32x4*)(KDl + o_ + 4 * j4) = (f32x4){kk_[4 * j4] * (1.f + (a_[0] - 1.f) * ka_[0]), kk_[4 * j4 + 1] * (1.f + (a_[1] - 1.f) * ka_[1]), kk_[4 * j4 + 2] * (1.f + (a_[2] - 1.f) * ka_[2]), kk_[4 * j4 + 3] * (1.f + (a_[3] - 1.f) * ka_[3])}; } } \
        } while (0)
        P_LOAD(0);
        P_COMPUTE(0);
        P_LOAD(1);
        __syncthreads();
        for (int c = 0; c < NCH; ++c) {
            if (c + 1 < NCH) { P_COMPUTE(c + 1); if (c + 2 < NCH) P_LOAD(c + 2); }
            __syncthreads();
        }
#undef P_LOAD
#undef P_COMPUTE
    } else {
        const int ft = tid - 384;
        __syncthreads();
        for (int c = 0; c < NCH; ++c) {
            if (c > 0) { const LAS float* YBl = YB0 + ((c - 1) & 1) * 1024;
#pragma unroll
                for (int i = 0; i < 2; ++i) { const int idx = ft + 128 * i, tf = idx >> 3, r4 = (idx & 7) * 4; const size_t row = (size_t)scan_row(b, dir, (c - 1) * SCH + tf);
                    *(f32x4*)(YS + row * RWW + 64 * h + 32 * half + r4) = *(const LAS f32x4*)(YBl + tf * 32 + r4); } }
            __syncthreads();
        }
        { const LAS float* YBl = YB0 + ((NCH - 1) & 1) * 1024;
#pragma unroll
            for (int i = 0; i < 2; ++i) { const int idx = ft + 128 * i, tf = idx >> 3, r4 = (idx & 7) * 4; const size_t row = (size_t)scan_row(b, dir, (NCH - 1) * SCH + tf);
                *(f32x4*)(YS + row * RWW + 64 * h + 32 * half + r4) = *(const LAS f32x4*)(YBl + tf * 32 + r4); } }
    }
    __syncthreads();
}

constexpr int CK = 16, NCK = (CTXL + SEQ) / CK;
constexpr int CS_KT = 0, CS_RT = 2048, CS_BH = 4096, CS_VT = 8192, CS_NKT = 10240, CS_TT = 10752, CS_MT = 11264, CS_GC = 12288, CS_SET = 12544;
constexpr int CS_PRIV = 8 * CS_SET;
constexpr int CS_PRIV_SZ = 11264;
constexpr int CS_PAR = CS_PRIV + 4 * CS_PRIV_SZ;
static_assert(CS_PAR + 1024 <= LDS_BYTES - 64, "chunked scan LDS");
__device__ __forceinline__ bf16x8 mk8(u32x2 lo, u32x2 hi) { return __builtin_bit_cast(bf16x8, (u32x4){lo.x, lo.y, hi.x, hi.y}); }
__device__ __forceinline__ void scan_chunked(Frame& F, int layer, int b, int h, int dir) {
    const bf16_t* Z = (const bf16_t*)(FWS(F) + WS_Z);
    bf16_t* YS = (bf16_t*)(FWS(F) + WS_YS) + (size_t)dir * NTOK * RWW;
    const int lane = F.lane, wave = F.wave, fr = lane & 15, fg = lane >> 4;
#define CK_BAR() do { asm volatile("s_waitcnt lgkmcnt(0)" ::: "memory"); __builtin_amdgcn_s_barrier(); asm volatile("" ::: "memory"); } while (0)
    constexpr int NBAR = NCK + 4;
    { LAS float* PAR = (LAS float*)(F.lds + CS_PAR); const int t_ = F.tid;
      if (t_ < 256) { const int which = t_ >> 6, cch = t_ & 63;
          const float* src = which == 0 ? F.tab[I_RW0] + (size_t)(layer * 2 + dir) * 256 : which == 1 ? F.tab[I_RA0] + (size_t)(layer * 2 + dir) * 256 : which == 2 ? F.tab[I_RKK] + (size_t)layer * 256 : F.tab[I_RKA] + (size_t)layer * 256;
          PAR[t_] = src[64 * h + cch]; }
      __syncthreads(); }
    if (wave < 4) {
        const int i = 16 * wave + fr;
        f32x4 ST[4];
#pragma unroll
        for (int jt = 0; jt < 4; ++jt) ST[jt] = (f32x4){0.f, 0.f, 0.f, 0.f};
        CK_BAR(); CK_BAR(); CK_BAR(); CK_BAR();
        for (int c = 0; c < NCK; ++c) {
            const LAS unsigned char* bs = F.lds + (((c & 3) * 2 + ((c >> 2) & 1)) * CS_SET);
            const LAS bf16_t* KT = (const LAS bf16_t*)(bs + CS_KT); const LAS bf16_t* RT = (const LAS bf16_t*)(bs + CS_RT); const LAS bf16_t* BH = (const LAS bf16_t*)(bs + CS_BH);
            const LAS bf16_t* VT = (const LAS bf16_t*)(bs + CS_VT); const LAS bf16_t* NKT = (const LAS bf16_t*)(bs + CS_NKT); const LAS bf16_t* TT = (const LAS bf16_t*)(bs + CS_TT);
            const LAS bf16_t* MT = (const LAS bf16_t*)(bs + CS_MT); const LAS float* GC = (const LAS float*)(bs + CS_GC);
            bf16x8 Sb[2];
#pragma unroll
            for (int ks = 0; ks < 2; ++ks) { u32x4 o; o.x = pk2(ST[2 * ks][0], ST[2 * ks][1]); o.y = pk2(ST[2 * ks][2], ST[2 * ks][3]); o.z = pk2(ST[2 * ks + 1][0], ST[2 * ks + 1][1]); o.w = pk2(ST[2 * ks + 1][2], ST[2 * ks + 1][3]); Sb[ks] = __builtin_bit_cast(bf16x8, o); }
            const u32x4 z4 = (u32x4){0u, 0u, 0u, 0u};
            f32x4 WT = (f32x4){0.f, 0.f, 0.f, 0.f};
#pragma unroll
            for (int ks = 0; ks < 2; ++ks) WT = __builtin_amdgcn_mfma_f32_16x16x32_bf16(mk8(*(const LAS u32x2*)(KT + fr * 64 + 32 * ks + 4 * fg), *(const LAS u32x2*)(KT + fr * 64 + 32 * ks + 16 + 4 * fg)), Sb[ks], WT, 0, 0, 0);
            { const u32x4 an = *(const LAS u32x4*)(NKT + fr * 16 + 8 * (fg & 1)), bv = *(const LAS u32x4*)(VT + i * 16 + 8 * (fg & 1));
              WT = __builtin_amdgcn_mfma_f32_16x16x32_bf16(__builtin_bit_cast(bf16x8, fg < 2 ? an : z4), __builtin_bit_cast(bf16x8, fg < 2 ? bv : z4), WT, 0, 0, 0); }
            f32x4 UT;
            { const u32x2 at = *(const LAS u32x2*)(TT + fr * 16 + 4 * fg); u32x4 bw; bw.x = pk2(WT[0], WT[1]); bw.y = pk2(WT[2], WT[3]); bw.z = 0u; bw.w = 0u;
              UT = __builtin_amdgcn_mfma_f32_16x16x32_bf16(__builtin_bit_cast(bf16x8, (u32x4){at.x, at.y, 0u, 0u}), __builtin_bit_cast(bf16x8, bw), (f32x4){0.f, 0.f, 0.f, 0.f}, 0, 0, 0); }
            bf16x8 Buv;
            { const u32x2 vv = *(const LAS u32x2*)(VT + i * 16 + 4 * fg); u32x4 o; o.x = pk2(UT[0], UT[1]); o.y = pk2(UT[2], UT[3]); o.z = vv.x; o.w = vv.y; Buv = __builtin_bit_cast(bf16x8, o); }
            f32x4 YT = (f32x4){0.f, 0.f, 0.f, 0.f};
#pragma unroll
            for (int ks = 0; ks < 2; ++ks) YT = __builtin_amdgcn_mfma_f32_16x16x32_bf16(mk8(*(const LAS u32x2*)(RT + fr * 64 + 32 * ks + 4 * fg), *(const LAS u32x2*)(RT + fr * 64 + 32 * ks + 16 + 4 * fg)), Sb[ks], YT, 0, 0, 0);
            YT = __builtin_amdgcn_mfma_f32_16x16x32_bf16(*(const LAS bf16x8*)(MT + fr * 32 + 8 * fg), Buv, YT, 0, 0, 0);
#pragma unroll
            for (int rg = 0; rg < 4; ++rg) { const size_t row = (size_t)scan_row(b, dir, c * CK + 4 * fg + rg); YS[row * RWW + 64 * h + i] = (bf16_t)f2bf(YT[rg]); }
#pragma unroll
            for (int jt = 0; jt < 4; ++jt) { const f32x4 gc = *(const LAS f32x4*)(GC + 16 * jt + 4 * fg);
                ST[jt] = __builtin_amdgcn_mfma_f32_16x16x32_bf16(*(const LAS bf16x8*)(BH + (16 * jt + fr) * 32 + 8 * fg), Buv, ST[jt] * gc, 0, 0, 0); }
            CK_BAR();
        }
    } else {
        const int p = wave - 4;
        LAS unsigned char* priv = F.lds + CS_PRIV + p * CS_PRIV_SZ;
        LAS bf16_t* BT = (LAS bf16_t*)priv; LAS bf16_t* KDT = (LAS bf16_t*)(priv + 2048); LAS float* NB = (LAS float*)(priv + 4096);
        const bf16_t* WUP = (const bf16_t*)(FWS(F) + WS_WUPT) + ((size_t)(layer * 2 + dir) * 256 + 64 * h + fr) * 64 + 8 * fg;
        const bf16_t* AUP = (const bf16_t*)(FWS(F) + WS_AUPT) + ((size_t)(layer * 2 + dir) * 256 + 64 * h + fr) * 64 + 8 * fg;
        const LAS float* W0Q = (const LAS float*)(F.lds + CS_PAR) + fr; const LAS float* A0Q = W0Q + 64; const LAS float* KKQ = W0Q + 128; const LAS float* KAQ = W0Q + 192;
        LAS bf16_t* RAW = (LAS bf16_t*)(priv + 5120);
        const int tl = lane >> 2, q16 = (lane & 3) * 16;
        u32x4 pw0, pw1, pa0, pa1, pr0, pr1, pk0, pk1, pv0, pv1;
#define CK_LOAD(cc) do { \
        { const size_t zr = (size_t)scan_row(b, dir, (cc) * CK + fr) * DINP + 64 * dir + 8 * fg; \
          pw0 = *(const u32x4*)(Z + zr + ZW); pw1 = *(const u32x4*)(Z + zr + ZW + 32); pa0 = *(const u32x4*)(Z + zr + ZA); pa1 = *(const u32x4*)(Z + zr + ZA + 32); } \
        { const size_t zr = (size_t)scan_row(b, dir, (cc) * CK + tl) * DINP + 64 * h + q16; \
          pr0 = *(const u32x4*)(Z + zr + ZR); pr1 = *(const u32x4*)(Z + zr + ZR + 8); pk0 = *(const u32x4*)(Z + zr + ZK); pk1 = *(const u32x4*)(Z + zr + ZK + 8); \
          pv0 = *(const u32x4*)(Z + zr + ZV); pv1 = *(const u32x4*)(Z + zr + ZV + 8); } } while (0)
        CK_LOAD(p);
        int nbar = 0;
        for (int c = p; c < NCK; c += 4) {
            LAS unsigned char* bs = F.lds + (((c & 3) * 2 + ((c >> 2) & 1)) * CS_SET);
            LAS bf16_t* KT = (LAS bf16_t*)(bs + CS_KT); LAS bf16_t* RT = (LAS bf16_t*)(bs + CS_RT); LAS bf16_t* BH = (LAS bf16_t*)(bs + CS_BH);
            LAS bf16_t* VT = (LAS bf16_t*)(bs + CS_VT); LAS bf16_t* NKT = (LAS bf16_t*)(bs + CS_NKT); LAS bf16_t* TT = (LAS bf16_t*)(bs + CS_TT);
            LAS bf16_t* MT = (LAS bf16_t*)(bs + CS_MT); LAS float* GC = (LAS float*)(bs + CS_GC);
            f32x4 dl[4], av[4];
            {
                bf16x8 bwf[4][2], baf[4][2];
#pragma unroll
                for (int ct = 0; ct < 4; ++ct) { bwf[ct][0] = *(const bf16x8*)(WUP + ct * 1024); bwf[ct][1] = *(const bf16x8*)(WUP + ct * 1024 + 32); baf[ct][0] = *(const bf16x8*)(AUP + ct * 1024); baf[ct][1] = *(const bf16x8*)(AUP + ct * 1024 + 32); }
                bf16x8 aw[2];
                { float f[8]; u32x4 o; unpack8(pw0, f); o.x = pk2(ftanh(f[0]), ftanh(f[1])); o.y = pk2(ftanh(f[2]), ftanh(f[3])); o.z = pk2(ftanh(f[4]), ftanh(f[5])); o.w = pk2(ftanh(f[6]), ftanh(f[7])); aw[0] = __builtin_bit_cast(bf16x8, o);
                  unpack8(pw1, f); o.x = pk2(ftanh(f[0]), ftanh(f[1])); o.y = pk2(ftanh(f[2]), ftanh(f[3])); o.z = pk2(ftanh(f[4]), ftanh(f[5])); o.w = pk2(ftanh(f[6]), ftanh(f[7])); aw[1] = __builtin_bit_cast(bf16x8, o); }
#pragma unroll
                for (int ct = 0; ct < 4; ++ct) {
                    f32x4 accw = (f32x4){0.f, 0.f, 0.f, 0.f}, acca = (f32x4){0.f, 0.f, 0.f, 0.f}; const float w0c = W0Q[16 * ct], a0c = A0Q[16 * ct];
                    accw = __builtin_amdgcn_mfma_f32_16x16x32_bf16(aw[0], bwf[ct][0], accw, 0, 0, 0); accw = __builtin_amdgcn_mfma_f32_16x16x32_bf16(aw[1], bwf[ct][1], accw, 0, 0, 0);
                    acca = __builtin_amdgcn_mfma_f32_16x16x32_bf16(__builtin_bit_cast(bf16x8, pa0), baf[ct][0], acca, 0, 0, 0); acca = __builtin_amdgcn_mfma_f32_16x16x32_bf16(__builtin_bit_cast(bf16x8, pa1), baf[ct][1], acca, 0, 0, 0);
#pragma unroll
                    for (int rg = 0; rg < 4; ++rg) { dl[ct][rg] = -0.6065306597126334f * fsigmoid(accw[rg] + w0c); av[ct][rg] = fsigmoid(acca[rg] + a0c); }
                }
            }
            { LAS bf16_t* d = RAW + tl * 64 + q16; *(LAS u32x4*)d = pr0; *(LAS u32x4*)(d + 8) = pr1; *(LAS u32x4*)(d + 1024) = pk0; *(LAS u32x4*)(d + 1024 + 8) = pk1; *(LAS u32x4*)(d + 2048) = pv0; *(LAS u32x4*)(d + 2048 + 8) = pv1; }
            if (c + 4 < NCK) CK_LOAD(c + 4);
            asm volatile("s_waitcnt lgkmcnt(0)" ::: "memory");
            CK_BAR(); ++nbar;
            float inv[4];
#pragma unroll
            for (int rg = 0; rg < 4; ++rg) {
                const LAS bf16_t* zp = RAW + (4 * fg + rg) * 64 + fr;
                float ss = 0.f;
#pragma unroll
                for (int ct = 0; ct < 4; ++ct) { const float q = bf2f(zp[1024 + 16 * ct]) * KKQ[16 * ct]; ss += q * q; }
                inv[rg] = rsqrtf(sum16(ss) + 1e-12f);
            }
            f32x4 lg[4]; float lgC[4];
#pragma unroll
            for (int ct = 0; ct < 4; ++ct) {
                lg[ct][0] = dl[ct][0]; lg[ct][1] = lg[ct][0] + dl[ct][1]; lg[ct][2] = lg[ct][1] + dl[ct][2]; lg[ct][3] = lg[ct][2] + dl[ct][3];
                const float tot = lg[ct][3];
                const float t1 = __shfl(tot, (lane + 48) & 63), t2 = __shfl(tot, (lane + 32) & 63), t3 = __shfl(tot, (lane + 16) & 63);
                const float off = (fg >= 1 ? t1 : 0.f) + (fg >= 2 ? t2 : 0.f) + (fg >= 3 ? t3 : 0.f);
                lg[ct] = lg[ct] + off;
                lgC[ct] = __shfl(lg[ct][3], 48 + fr);
            }
            CK_BAR(); ++nbar;
            float rx[4][4], kx[4][4], vx[4][4];
#pragma unroll
            for (int rg = 0; rg < 4; ++rg)
#pragma unroll
                for (int ct = 0; ct < 4; ++ct) { const LAS bf16_t* zp = RAW + (4 * fg + rg) * 64 + 16 * ct + fr; rx[ct][rg] = bf2f(zp[0]); kx[ct][rg] = bf2f(zp[1024]); vx[ct][rg] = bf2f(zp[2048]); }
            asm volatile("s_waitcnt lgkmcnt(0)" ::: "memory");
#pragma unroll
            for (int ct = 0; ct < 4; ++ct) {
                const int j = 16 * ct + fr; const float gC = __expf(lgC[ct]); const float kkc = KKQ[16 * ct], kac = KAQ[16 * ct];
                float nb[4], kh[4];
                float gprev = __expf(lg[ct][0] - dl[ct][0]);
#pragma unroll
                for (int rg = 0; rg < 4; ++rg) {
                    const int t = 4 * fg + rg;
                    const float kappa = kx[ct][rg] * kkc * inv[rg], a_ = av[ct][rg], beta = kappa * a_, kd = kx[ct][rg] * (1.f + (a_ - 1.f) * kac);
                    const float g = __expf(lg[ct][rg]), gi = __builtin_amdgcn_rcpf(g), gcr = gC * gi;
                    const unsigned w0 = pk2(gprev * kappa, g * rx[ct][rg]), w1 = pk2(gi * beta, gi * kd);
                    KT[t * 64 + j] = (bf16_t)(w0 & 0xffffu); RT[t * 64 + j] = (bf16_t)(w0 >> 16);
                    BT[t * 64 + j] = (bf16_t)(w1 & 0xffffu); KDT[t * 64 + j] = (bf16_t)(w1 >> 16);
                    nb[rg] = -beta * gcr; kh[rg] = kd * gcr; gprev = g;
                }
                *(LAS u32x2*)(BH + j * 32 + 8 * fg) = (u32x2){pk2(nb[0], nb[1]), pk2(nb[2], nb[3])}; *(LAS u32x2*)(BH + j * 32 + 8 * fg + 4) = (u32x2){pk2(kh[0], kh[1]), pk2(kh[2], kh[3])};
                *(LAS u32x2*)(VT + j * 16 + 4 * fg) = (u32x2){pk2(vx[ct][0], vx[ct][1]), pk2(vx[ct][2], vx[ct][3])};
                if (fg == 0) GC[j] = gC;
            }
            asm volatile("s_waitcnt lgkmcnt(0)" ::: "memory");
            CK_BAR(); ++nbar;
            {
                f32x4 g00 = (f32x4){0.f, 0.f, 0.f, 0.f}, g01 = g00, g10 = g00, g11 = g00;
#pragma unroll
                for (int ks = 0; ks < 2; ++ks) {
                    const bf16x8 ab = *(const LAS bf16x8*)(BT + fr * 64 + 32 * ks + 8 * fg), ak = *(const LAS bf16x8*)(KDT + fr * 64 + 32 * ks + 8 * fg);
                    const bf16x8 bk = *(const LAS bf16x8*)(KT + fr * 64 + 32 * ks + 8 * fg), br = *(const LAS bf16x8*)(RT + fr * 64 + 32 * ks + 8 * fg);
                    g00 = __builtin_amdgcn_mfma_f32_16x16x32_bf16(ab, bk, g00, 0, 0, 0); g01 = __builtin_amdgcn_mfma_f32_16x16x32_bf16(ab, br, g01, 0, 0, 0);
                    g10 = __builtin_amdgcn_mfma_f32_16x16x32_bf16(ak, bk, g10, 0, 0, 0); g11 = __builtin_amdgcn_mfma_f32_16x16x32_bf16(ak, br, g11, 0, 0, 0);
                }
                float nk[4], mb[4], mk[4];
#pragma unroll
                for (int rg = 0; rg < 4; ++rg) { const int m = 4 * fg + rg, n = fr;
                    nk[rg] = (m < n) ? g10[rg] : 0.f; mb[rg] = (m <= n) ? -g01[rg] : 0.f; mk[rg] = (m <= n) ? g11[rg] : 0.f; }
                *(LAS u32x2*)(NKT + fr * 16 + 4 * fg) = (u32x2){pk2(nk[0], nk[1]), pk2(nk[2], nk[3])};
                *(LAS u32x2*)(MT + fr * 32 + 8 * fg) = (u32x2){pk2(mb[0], mb[1]), pk2(mb[2], mb[3])}; *(LAS u32x2*)(MT + fr * 32 + 8 * fg + 4) = (u32x2){pk2(mk[0], mk[1]), pk2(mk[2], mk[3])};
                float n0 = g00[0], n1 = g00[1], n2 = g00[2], n3 = g00[3];
                asm volatile("s_nop 15\n\ts_nop 15" : "+v"(n0), "+v"(n1), "+v"(n2), "+v"(n3));
                float Tr[16];
#pragma unroll
                for (int s = 0; s < 16; ++s) { float a0 = (fr == s) ? 1.f : 0.f, a1 = 0.f;
#pragma unroll
                    for (int r = 0; r < s; ++r) { const float nsel = (r & 3) == 0 ? n0 : (r & 3) == 1 ? n1 : (r & 3) == 2 ? n2 : n3; const float nrs = __builtin_bit_cast(float, __builtin_amdgcn_readlane(__builtin_bit_cast(int, nsel), s + 16 * (r >> 2)));
                        if (r & 1) a1 -= Tr[r] * nrs; else a0 -= Tr[r] * nrs; }
                    Tr[s] = a0 + a1; __builtin_amdgcn_sched_barrier(0); }
                if (lane < 16) {
#pragma unroll
                    for (int s = 0; s < 16; s += 2) { const unsigned w = pk2(Tr[s], Tr[s + 1]); TT[s * 16 + fr] = (bf16_t)(w & 0xffffu); TT[(s + 1) * 16 + fr] = (bf16_t)(w >> 16); }
                }
            }
            asm volatile("s_waitcnt lgkmcnt(0)" ::: "memory");
            CK_BAR(); ++nbar;
        }
        for (; nbar < NBAR; ++nbar) CK_BAR();
#undef CK_LOAD
    }
    __syncthreads();
}
#undef CK_BAR

struct NaState { bf16x8 qf[4][2]; f32x4 oacc[4][4]; float mrun[4], lrun[4]; int mb[4], bq[4]; };
template <int MODE> __device__ __forceinline__ constexpr bool na_need(int qt, int T) {
    if (MODE == 2) return true;
    const int kt = 2 * MODE + T;
    return qt == 0 ? (kt <= 1) : qt == 1 ? (kt <= 2) : qt == 2 ? (kt >= 1) : (kt >= 2);
}
struct NaLd { bf16x8 kf[2][2]; int krow0; };
__device__ __forceinline__ void na_load(NaLd& ld, const bf16_t* Z, int krow0, int h, int lane, int fr, int fg) {
    ld.krow0 = krow0;
#pragma unroll
    for (int T = 0; T < 2; ++T)
#pragma unroll
        for (int ks = 0; ks < 2; ++ks) ld.kf[T][ks] = *(const bf16x8*)(Z + (size_t)(krow0 + 16 * T + fr) * DINP + ZNK + 64 * h + 32 * ks + 8 * fg);
}
template <int MODE> __device__ __forceinline__ void na_slice(NaState& st, const NaLd& ld, const bf16_t* Z, int h, int dr, LAS bf16_t* Vt, const LAS float* bias, int lane, int fr, int fg) {
    u32x4 vv[4];
#pragma unroll
    for (int i = 0; i < 4; ++i) { const int p = lane + 64 * i, kk = p >> 3, d0 = (p & 7) * 8; vv[i] = *(const u32x4*)(Z + (size_t)(ld.krow0 + kk) * DINP + ZNV + 64 * h + d0); }
    f32x4 sacc[2][4];
#pragma unroll
    for (int T = 0; T < 2; ++T)
#pragma unroll
        for (int qt = 0; qt < 4; ++qt) if (na_need<MODE>(qt, T)) { sacc[T][qt] = (f32x4){0.f, 0.f, 0.f, 0.f};
#pragma unroll
            for (int ks = 0; ks < 2; ++ks) sacc[T][qt] = __builtin_amdgcn_mfma_f32_16x16x32_bf16(ld.kf[T][ks], st.qf[qt][ks], sacc[T][qt], 0, 0, 0); }
#pragma unroll
    for (int i = 0; i < 4; ++i) { const int p = lane + 64 * i, kk = p >> 3, d0 = (p & 7) * 8; *(LAS u32x4*)(Vt + kk * 72 + d0) = vv[i]; }
    bf16x8 pf[4];
#pragma unroll
    for (int qt = 0; qt < 4; ++qt) if (na_need<MODE>(qt, 0) || na_need<MODE>(qt, 1)) {
        float mx = -3.0e38f;
        const LAS float* bp = bias + dr * 31 + 32 * MODE + st.bq[qt];
#pragma unroll
        for (int T = 0; T < 2; ++T) if (na_need<MODE>(qt, T))
#pragma unroll
            for (int rg = 0; rg < 4; ++rg) {
                float s = sacc[T][qt][rg];
                if (MODE != 2) { const unsigned u = (unsigned)(32 * MODE + 16 * T + rg + st.mb[qt]); s = (u < 16u) ? s + bp[16 * T + rg] : -1.0e30f; }
                sacc[T][qt][rg] = s; mx = fmaxf(mx, s);
            }
        mx = fmaxf(mx, __shfl_xor(mx, 16)); mx = fmaxf(mx, __shfl_xor(mx, 32));
        const float mold = st.mrun[qt], mnew = fmaxf(mold, mx);
        if (__builtin_amdgcn_ballot_w64(mnew > mold) != 0ull) {
            const float alpha = __builtin_amdgcn_exp2f(mold - mnew);
            st.mrun[qt] = mnew; st.lrun[qt] *= alpha;
#pragma unroll
            for (int dt = 0; dt < 4; ++dt) st.oacc[dt][qt] = st.oacc[dt][qt] * alpha;
        }
        float ps = 0.f; float p[8];
#pragma unroll
        for (int T = 0; T < 2; ++T)
#pragma unroll
            for (int rg = 0; rg < 4; ++rg) { if (na_need<MODE>(qt, T)) { const float e = __builtin_amdgcn_exp2f(sacc[T][qt][rg] - mnew); p[4 * T + rg] = e; ps += e; } else p[4 * T + rg] = 0.f; }
        ps += __shfl_xor(ps, 16); ps += __shfl_xor(ps, 32);
        st.lrun[qt] += ps;
        u32x4 o; o.x = pk2(p[0], p[1]); o.y = pk2(p[2], p[3]); o.z = pk2(p[4], p[5]); o.w = pk2(p[6], p[7]); pf[qt] = __builtin_bit_cast(bf16x8, o);
    }
    asm volatile("s_waitcnt lgkmcnt(0)" ::: "memory");
    {
        const LAS bf16_t* vb = Vt + (4 * fg + ((lane & 15) >> 2)) * 72 + 4 * (lane & 3);
#pragma unroll
        for (int dt = 0; dt < 4; ++dt) {
            typedef short s16x4 __attribute__((ext_vector_type(4)));
            const s16x4 lo = __builtin_amdgcn_ds_read_tr16_b64_v4i16((LAS s16x4*)(vb + 16 * dt)), hi = __builtin_amdgcn_ds_read_tr16_b64_v4i16((LAS s16x4*)(vb + 16 * 72 + 16 * dt));
            const bf16x8 vf = (bf16x8){lo[0], lo[1], lo[2], lo[3], hi[0], hi[1], hi[2], hi[3]};
#pragma unroll
            for (int qt = 0; qt < 4; ++qt) if (na_need<MODE>(qt, 0) || na_need<MODE>(qt, 1)) st.oacc[dt][qt] = __builtin_amdgcn_mfma_f32_16x16x32_bf16(vf, pf[qt], st.oacc[dt][qt], 0, 0, 0);
        }
    }
    asm volatile("s_waitcnt lgkmcnt(0)" ::: "memory");
}
__device__ __forceinline__ void na_unit(Frame& F, int layer, int b, int h, int r, bool ctxq) {
    const bf16_t* Z = (const bf16_t*)(FWS(F) + WS_Z);
    bf16_t* Y = (bf16_t*)(FWS(F) + WS_H);
    const int lane = F.lane, fr = lane & 15, fg = lane >> 4;
    LAS unsigned char* wl = F.lds + F.wave * 8192;
    LAS bf16_t* Vt = (LAS bf16_t*)wl;
    LAS float* bias = (LAS float*)(wl + 5120);
    const float SC2 = 0.125f * 1.4426950408889634f;
    if (!ctxq) { const float* rp = F.tab[I_RPB] + ((size_t)layer * 8 + h) * 465; float bv[8];
#pragma unroll
        for (int it = 0; it < 8; ++it) { const int i = lane + 64 * it; bv[it] = rp[i < 465 ? i : 464]; }
#pragma unroll
        for (int it = 0; it < 8; ++it) { const int i = lane + 64 * it; if (i < 465) bias[i] = bv[it] * 1.4426950408889634f; } }
    const int qrow0 = ctxq ? NLAT + b * CTXL + r * 64 : b * SEQ + r * 64;
    NaState st;
#pragma unroll
    for (int qt = 0; qt < 4; ++qt) {
#pragma unroll
        for (int ks = 0; ks < 2; ++ks) { const u32x4 w = *(const u32x4*)(Z + (size_t)(qrow0 + 16 * qt + fr) * DINP + ZNQ + 64 * h + 32 * ks + 8 * fg); float f[8]; unpack8(w, f);
            u32x4 o; o.x = pk2(f[0] * SC2, f[1] * SC2); o.y = pk2(f[2] * SC2, f[3] * SC2); o.z = pk2(f[4] * SC2, f[5] * SC2); o.w = pk2(f[6] * SC2, f[7] * SC2); st.qf[qt][ks] = __builtin_bit_cast(bf16x8, o); }
        const int cq = 16 * qt + fr, c0 = min(max(cq - 8, 0), 48);
        st.mb[qt] = 4 * fg - c0; st.bq[qt] = 4 * fg - cq + 15;
        st.mrun[qt] = -3.0e38f; st.lrun[qt] = 0.f;
#pragma unroll
        for (int dt = 0; dt < 4; ++dt) st.oacc[dt][qt] = (f32x4){0.f, 0.f, 0.f, 0.f};
    }
    NaLd la, lb;
    const int crow = NLAT + b * CTXL;
    if (!ctxq) {
        const int row0 = min(max(r - 4, 0), 24), kbase = b * SEQ + row0 * 64;
        na_load(la, Z, kbase, h, lane, fr, fg);
#pragma nounroll
        for (int i = 0; i < 8; ++i) {
            const int dr = row0 + i - r + 7;
            na_load(lb, Z, kbase + 64 * i + 32, h, lane, fr, fg);
            na_slice<0>(st, la, Z, h, dr, Vt, bias, lane, fr, fg);
            na_load(la, Z, i < 7 ? kbase + 64 * (i + 1) : crow, h, lane, fr, fg);
            na_slice<1>(st, lb, Z, h, dr, Vt, bias, lane, fr, fg);
        }
    } else na_load(la, Z, crow, h, lane, fr, fg);
#pragma nounroll
    for (int j = 0; j < 8; j += 2) {
        na_load(lb, Z, crow + 32 * (j + 1), h, lane, fr, fg);
        na_slice<2>(st, la, Z, h, 0, Vt, bias, lane, fr, fg);
        if (j + 2 < 8) na_load(la, Z, crow + 32 * (j + 2), h, lane, fr, fg);
        na_slice<2>(st, lb, Z, h, 0, Vt, bias, lane, fr, fg);
    }
#pragma unroll
    for (int qt = 0; qt < 4; ++qt) { const float il = 1.0f / st.lrun[qt];
#pragma unroll
        for (int dt = 0; dt < 4; ++dt) { const f32x4 o = st.oacc[dt][qt] * il; u32x2 w; w.x = pk2(o[0], o[1]); w.y = pk2(o[2], o[3]);
            *(u32x2*)(Y + (size_t)(qrow0 + 16 * qt + fr) * D + RWW + 64 * h + 16 * dt + 4 * fg) = w; } }
}

__device__ __forceinline__ void sc_items(Frame& F, int layer, int nrows, size_t gt, size_t GT) {
    const bf16_t* Z = (const bf16_t*)(FWS(F) + WS_Z); bf16_t* Y = (bf16_t*)(FWS(F) + WS_H);
    const float* cw = F.tab[I_SCW] + (size_t)layer * 3 * SCW;
    for (size_t it = gt; it < (size_t)nrows * 32; it += GT) {
        const int row = (int)(it >> 5), c0 = (int)(it & 31) * 8;
        const int tpos = row < NLAT ? (row & (SEQ - 1)) : ((row - NLAT) & (CTXL - 1)); const int tlen = row < NLAT ? SEQ : CTXL;
        const bf16_t* zr = Z + (size_t)row * DINP;
        float zb[8], u0[8], u1[8], u2[8], t0[8], t1[8];
        unpack8(*(const u32x4*)(zr + ZSB + c0), zb);
        unpack8(*(const u32x4*)(zr + ZSC + c0), t0); unpack8(*(const u32x4*)(zr + ZSX + c0), t1);
#pragma unroll
        for (int j = 0; j < 8; ++j) u1[j] = t0[j] * t1[j];
        if (tpos > 0) { unpack8(*(const u32x4*)(zr - DINP + ZSC + c0), t0); unpack8(*(const u32x4*)(zr - DINP + ZSX + c0), t1);
#pragma unroll
            for (int j = 0; j < 8; ++j) u0[j] = t0[j] * t1[j]; } else {
#pragma unroll
            for (int j = 0; j < 8; ++j) u0[j] = 0.f; }
        if (tpos < tlen - 1) { unpack8(*(const u32x4*)(zr + DINP + ZSC + c0), t0); unpack8(*(const u32x4*)(zr + DINP + ZSX + c0), t1);
#pragma unroll
            for (int j = 0; j < 8; ++j) u2[j] = t0[j] * t1[j]; } else {
#pragma unroll
            for (int j = 0; j < 8; ++j) u2[j] = 0.f; }
        float o[8];
#pragma unroll
        for (int j = 0; j < 8; ++j) o[j] = zb[j] * (u0[j] * cw[c0 + j] + u1[j] * cw[SCW + c0 + j] + u2[j] * cw[2 * SCW + c0 + j]);
        u32x4 w; w.x = pk2(o[0], o[1]); w.y = pk2(o[2], o[3]); w.z = pk2(o[4], o[5]); w.w = pk2(o[6], o[7]);
        *(u32x4*)(Y + (size_t)row * D + RWW + NAW + c0) = w;
    }
}

#ifndef REPMASK
#define REPMASK 0
#endif
__device__ __forceinline__ void mixer_phase(Frame& F, int layer) {
    const bool need_ctx = layer == 0;
    if (F.bid < 128) { for (int rep = 0; rep < 1 + ((REPMASK >> 10) & 1); ++rep) scan_chunked(F, layer, F.bid >> 3, (F.bid >> 1) & 3, F.bid & 1); }
    else sc_items(F, layer, need_ctx ? NTOK : NLAT, (size_t)(F.bid - 128) * NTHR + F.tid, (size_t)(F.G - 128) * NTHR);
    unsigned* ctr = (unsigned*)(FWS(F) + WS_CTL + 14336) + 64 * layer;
    const unsigned nun = NB * 32 * 8 + (need_ctx ? NB * 4 * 8 : 0);
    for (;;) {
        unsigned u = 0; if (F.lane == 0) u = __hip_atomic_fetch_add(ctr, 1u, __ATOMIC_RELAXED, __HIP_MEMORY_SCOPE_AGENT);
        u = (unsigned)__builtin_amdgcn_readfirstlane((int)u);
        if (u >= nun) break;
        if (u < NB * 32 * 8) na_unit(F, layer, u >> 8, u & 7, (u >> 3) & 31, false);
        else { const unsigned v = u - NB * 32 * 8; na_unit(F, layer, v >> 5, v & 7, (v >> 3) & 3, true); }
    }
}

__device__ __forceinline__ void rwkv_post_phase(Frame& F, int layer, int nrows) {
    const bf16_t* Z = (const bf16_t*)(FWS(F) + WS_Z); bf16_t* Y = (bf16_t*)(FWS(F) + WS_H);
    const bf16_t* YS0 = (const bf16_t*)(FWS(F) + WS_YS); const bf16_t* YS1 = YS0 + (size_t)NTOK * RWW;
    LAS bf16_t* gT = (LAS bf16_t*)F.lds;
    LAS bf16_t* gtile = (LAS bf16_t*)(F.lds + 256 * 272) + F.wave * (16 * 72);
    { const float* src = F.tab[I_RGUP] + (size_t)layer * 128 * 256;
      f32x4 gv[16];
#pragma unroll
      for (int it = 0; it < 16; ++it) gv[it] = *(const f32x4*)(src + 4 * (F.tid + NTHR * it));
#pragma unroll
      for (int it = 0; it < 16; ++it) { const int i4 = 4 * (F.tid + NTHR * it), k = i4 >> 8, ch = i4 & 255; const unsigned w0 = pk2(gv[it][0], gv[it][1]), w1 = pk2(gv[it][2], gv[it][3]);
          gT[ch * 136 + k] = (bf16_t)(w0 & 0xffffu); gT[(ch + 1) * 136 + k] = (bf16_t)(w0 >> 16); gT[(ch + 2) * 136 + k] = (bf16_t)(w1 & 0xffffu); gT[(ch + 3) * 136 + k] = (bf16_t)(w1 >> 16); } }
    __syncthreads();
    const int lane = F.lane, fr = lane & 15, fg = lane >> 4;
    const int tl = lane >> 2, q16 = (lane & 3) * 16;
    const int gw = F.bid * NWAVES + F.wave, NGW = F.G * NWAVES;
    const int nitems = (nrows / 16) * 4;
    for (int it = gw; it < nitems; it += NGW) {
        const int h = it & 3, row0 = (it >> 2) * 16;
        const size_t row = (size_t)row0 + tl; const int c0 = 64 * h + q16;
        u32x4 zg[4];
#pragma unroll
        for (int ks = 0; ks < 4; ++ks) zg[ks] = *(const u32x4*)(Z + (size_t)(row0 + fr) * DINP + ZG + 32 * ks + 8 * fg);
        const bf16_t* zr = Z + row * DINP + c0;
        const u32x4 ya0 = *(const u32x4*)(YS0 + row * RWW + c0), ya1 = *(const u32x4*)(YS0 + row * RWW + c0 + 8), yb0 = *(const u32x4*)(YS1 + row * RWW + c0), yb1 = *(const u32x4*)(YS1 + row * RWW + c0 + 8);
        const u32x4 wr0 = *(const u32x4*)(zr + ZR), wr1 = *(const u32x4*)(zr + ZR + 8), wk0 = *(const u32x4*)(zr + ZK), wk1 = *(const u32x4*)(zr + ZK + 8), wv0 = *(const u32x4*)(zr + ZV), wv1 = *(const u32x4*)(zr + ZV + 8);
        bf16x8 af[4];
#pragma unroll
        for (int ks = 0; ks < 4; ++ks) { float f[8]; unpack8(zg[ks], f);
            u32x4 o; o.x = pk2(fsigmoid(f[0]), fsigmoid(f[1])); o.y = pk2(fsigmoid(f[2]), fsigmoid(f[3])); o.z = pk2(fsigmoid(f[4]), fsigmoid(f[5])); o.w = pk2(fsigmoid(f[6]), fsigmoid(f[7])); af[ks] = __builtin_bit_cast(bf16x8, o); }
#pragma unroll
        for (int nt = 0; nt < 4; ++nt) {
            f32x4 acc = (f32x4){0.f, 0.f, 0.f, 0.f};
#pragma unroll
            for (int ks = 0; ks < 4; ++ks) acc = __builtin_amdgcn_mfma_f32_16x16x32_bf16(af[ks], *(const LAS bf16x8*)(gT + (64 * h + 16 * nt + fr) * 136 + 32 * ks + 8 * fg), acc, 0, 0, 0);
#pragma unroll
            for (int rg = 0; rg < 4; ++rg) gtile[(4 * fg + rg) * 72 + 16 * nt + fr] = (bf16_t)f2bf(acc[rg]);
        }
        asm volatile("s_waitcnt lgkmcnt(0)" ::: "memory");
        float y[16];
        { float ta[8], tb[8]; unpack8(ya0, ta); unpack8(yb0, tb);
#pragma unroll
          for (int e = 0; e < 8; ++e) y[e] = ta[e] + tb[e];
          unpack8(ya1, ta); unpack8(yb1, tb);
#pragma unroll
          for (int e = 0; e < 8; ++e) y[8 + e] = ta[e] + tb[e]; }
        float s1 = 0.f;
#pragma unroll
        for (int j = 0; j < 16; ++j) s1 += y[j];
        s1 += dppf<XOR1>(s1); s1 += dppf<XOR2>(s1);
        const float mu = s1 * (1.f / 64.f);
        float s2 = 0.f;
#pragma unroll
        for (int j = 0; j < 16; ++j) { y[j] -= mu; s2 += y[j] * y[j]; }
        s2 += dppf<XOR1>(s2); s2 += dppf<XOR2>(s2);
        const float rs = rsqrtf(s2 * (1.f / 64.f) + 64e-5f);
        float r[16], k[16], v[16], gte[16];
        { float t[8]; unpack8(wr0, t);
#pragma unroll
          for (int j = 0; j < 8; ++j) r[j] = t[j];
          unpack8(wr1, t);
#pragma unroll
          for (int j = 0; j < 8; ++j) r[8 + j] = t[j];
          unpack8(wk0, t);
#pragma unroll
          for (int j = 0; j < 8; ++j) k[j] = t[j];
          unpack8(wk1, t);
#pragma unroll
          for (int j = 0; j < 8; ++j) k[8 + j] = t[j];
          unpack8(wv0, t);
#pragma unroll
          for (int j = 0; j < 8; ++j) v[j] = t[j];
          unpack8(wv1, t);
#pragma unroll
          for (int j = 0; j < 8; ++j) v[8 + j] = t[j];
          unpack8(*(const LAS u32x4*)(gtile + tl * 72 + q16), t);
#pragma unroll
          for (int j = 0; j < 8; ++j) gte[j] = t[j];
          unpack8(*(const LAS u32x4*)(gtile + tl * 72 + q16 + 8), t);
#pragma unroll
          for (int j = 0; j < 8; ++j) gte[8 + j] = t[j]; }
        const float* lnx = F.tab[I_RLNX] + (size_t)layer * 256 + c0; const float* rk = F.tab[I_RRK] + (size_t)layer * 256 + c0;
        float bon = 0.f;
#pragma unroll
        for (int j = 0; j < 16; ++j) bon += r[j] * k[j] * rk[j];
        bon += dppf<XOR1>(bon); bon += dppf<XOR2>(bon);
        unsigned ow[8];
#pragma unroll
        for (int j = 0; j < 16; j += 2) { const float o0 = (y[j] * rs * lnx[j] + v[j] * bon) * gte[j], o1 = (y[j + 1] * rs * lnx[j + 1] + v[j + 1] * bon) * gte[j + 1]; ow[j >> 1] = pk2(o0, o1); }
        *(u32x4*)(Y + row * D + c0) = (u32x4){ow[0], ow[1], ow[2], ow[3]}; *(u32x4*)(Y + row * D + c0 + 8) = (u32x4){ow[4], ow[5], ow[6], ow[7]};
        asm volatile("s_waitcnt lgkmcnt(0)" ::: "memory");
    }
    __syncthreads();
}
__device__ __forceinline__ unsigned mono_of(float x) { const unsigned u = __builtin_bit_cast(unsigned, x); return u ^ ((unsigned)((int)u >> 31) | 0x80000000u); }
__device__ __forceinline__ float unmono(unsigned m) { const unsigned u = m ^ (~(unsigned)((int)m >> 31) | 0x80000000u); return __builtin_bit_cast(float, u); }
#define KCE(a, b) do { const unsigned _hi = (a) > (b) ? (a) : (b), _lo = (a) > (b) ? (b) : (a); (a) = _hi; (b) = _lo; } while (0)
__device__ __forceinline__ void ksort16(unsigned (&k)[16]) {
    KCE(k[0], k[1]); KCE(k[2], k[3]); KCE(k[0], k[2]); KCE(k[1], k[3]); KCE(k[1], k[2]); KCE(k[4], k[5]); KCE(k[6], k[7]); KCE(k[4], k[6]); KCE(k[5], k[7]); KCE(k[5], k[6]); KCE(k[0], k[4]); KCE(k[2], k[6]); KCE(k[2], k[4]); KCE(k[1], k[5]); KCE(k[3], k[7]); KCE(k[3], k[5]); KCE(k[1], k[2]); KCE(k[3], k[4]); KCE(k[5], k[6]); KCE(k[8], k[9]); KCE(k[10], k[11]); KCE(k[8], k[10]); KCE(k[9], k[11]); KCE(k[9], k[10]); KCE(k[12], k[13]); KCE(k[14], k[15]); KCE(k[12], k[14]); KCE(k[13], k[15]); KCE(k[13], k[14]); KCE(k[8], k[12]); KCE(k[10], k[14]); KCE(k[10], k[12]); KCE(k[9], k[13]); KCE(k[11], k[15]); KCE(k[11], k[13]); KCE(k[9], k[10]); KCE(k[11], k[12]); KCE(k[13], k[14]); KCE(k[0], k[8]); KCE(k[4], k[12]); KCE(k[4], k[8]); KCE(k[2], k[10]); KCE(k[6], k[14]); KCE(k[6], k[10]); KCE(k[2], k[4]); KCE(k[6], k[8]); KCE(k[10], k[12]); KCE(k[1], k[9]); KCE(k[5], k[13]); KCE(k[5], k[9]); KCE(k[3], k[11]); KCE(k[7], k[15]); KCE(k[7], k[11]); KCE(k[3], k[5]); KCE(k[7], k[9]); KCE(k[11], k[13]); KCE(k[1], k[2]); KCE(k[3], k[4]); KCE(k[5], k[6]); KCE(k[7], k[8]); KCE(k[9], k[10]); KCE(k[11], k[12]); KCE(k[13], k[14]);
}
__device__ __forceinline__ void kmerge16(unsigned (&a)[16], const unsigned (&b)[16]) {
#pragma unroll
    for (int i = 0; i < 16; ++i) a[i] = a[i] > b[15 - i] ? a[i] : b[15 - i];
#pragma unroll
    for (int stride = 8; stride > 0; stride >>= 1)
#pragma unroll
        for (int i = 0; i < 16; ++i) { const int j = i ^ stride; if (j > i) KCE(a[i], a[j]); }
}
__host__ __device__ constexpr int cand_slot(int a, int b) { int n = 0; for (int x = 0; x < 16; ++x) for (int y = 0; y < 16; ++y) { if (x == a && y == b) return n; if ((x + 1) * (y + 1) <= 16) ++n; } return n; }

namespace pg8 {
struct EpiTopk {
    static constexpr bool PERM = false, AFTER_DRAIN = true;
    int* IDX; float* GATE;
    __device__ __forceinline__ void dump(const f32x4 (&a)[2][4][2], LAS float* T, int wr, int wc, int fr, int fq) const {
#pragma unroll
        for (int bj = 0; bj < 2; ++bj)
#pragma unroll
            for (int m = 0; m < 4; ++m)
#pragma unroll
                for (int n = 0; n < 2; ++n) { LAS float* p = T + (wr * 64 + m * 16 + fr) * 257 + bj * HALF + wc * 32 + n * 16 + 4 * fq;
                    p[0] = a[bj][m][n][0]; p[1] = a[bj][m][n][1]; p[2] = a[bj][m][n][2]; p[3] = a[bj][m][n][3]; }
    }
    __device__ __forceinline__ void fused(f32x4 (&acc)[2][2][4][2], const Unit& u, int wr_, int wc_, int fr_, int fq_, LAS unsigned char* lds, int wid_, int lane_) const {
        LAS float* T = (LAS float*)lds;
        LAS unsigned* LX = (LAS unsigned*)lds;
        LAS unsigned* LF = (LAS unsigned*)lds + 256 * 17;
        int tid = threadIdx.x; asm volatile("" : "+v"(tid));
        const int lane = tid & 63, wid = tid >> 6, wr = wid >> 2, wc = wid & 3, fr = lane & 15, fq = lane >> 4;
        const int row = tid & 127, p = (tid >> 7) & 1, hf = tid >> 8;
#pragma nounroll
        for (int ai = 0; ai < 2; ++ai) {
            if (ai == 0) dump(acc[0], T, wr, wc, fr, fq); else dump(acc[1], T, wr, wc, fr, fq);
            __syncthreads();
            unsigned top[16];
            {
                const LAS float* src = T + row * 257 + p * 128 + hf * 64;
#pragma nounroll
                for (int g = 0; g < 4; ++g) {
                    unsigned k[16];
#pragma unroll
                    for (int j = 0; j < 16; ++j) k[j] = (mono_of(src[g * 16 + j]) & ~127u) | (unsigned)(127 - (hf * 64 + g * 16 + j));
                    ksort16(k);
                    if (g == 0) {
#pragma unroll
                        for (int j = 0; j < 16; ++j) top[j] = k[j];
                    } else kmerge16(top, k);
                }
            }
            __syncthreads();
            if (hf == 1) {
#pragma unroll
                for (int j = 0; j < 16; ++j) LX[(tid & 255) * 17 + j] = top[j];
            }
            __syncthreads();
            if (hf == 0) {
                unsigned o[16];
#pragma unroll
                for (int j = 0; j < 16; ++j) o[j] = LX[tid * 17 + j];
                kmerge16(top, o);
#pragma unroll
                for (int j = 0; j < 16; ++j) LF[(row * 2 + p) * 17 + j] = top[j];
            }
            __syncthreads();
            if (tid < 128) {
                const LAS unsigned* K1 = LF + (tid * 2) * 17; const LAS unsigned* K2 = K1 + 17;
                float s1[16], s2[16];
#pragma unroll
                for (int j = 0; j < 16; ++j) { s1[j] = unmono(K1[j] & ~127u); s2[j] = unmono(K2[j] & ~127u); }
                unsigned best[16];
#pragma unroll
                for (int g = 0; g < 4; ++g) {
                    unsigned k[16];
#pragma unroll
                    for (int j = 0; j < 16; ++j) k[j] = 0u;
#pragma unroll
                    for (int a = 0; a < 16; ++a)
#pragma unroll
                        for (int b = 0; b < 16; ++b) if ((a + 1) * (b + 1) <= 16) { constexpr int dummy = 0; (void)dummy; const int sl = cand_slot(a, b); if ((sl >> 4) == g) k[sl & 15] = (mono_of(s1[a] + s2[b]) & ~255u) | (unsigned)(255 - (a * 16 + b)); }
                    ksort16(k);
                    if (g == 0) {
#pragma unroll
                        for (int j = 0; j < 16; ++j) best[j] = k[j];
                    } else kmerge16(best, k);
                }
                const float v0 = unmono(best[0] & ~255u); float e[16], es = 0.f;
#pragma unroll
                for (int j = 0; j < 16; ++j) { e[j] = __expf(unmono(best[j] & ~255u) - v0); es += e[j]; }
                const float ies = 1.0f / es;
                const size_t token = (size_t)u.pm * BM + ai * HALF + tid;
                unsigned* io = (unsigned*)IDX + (token * 8 + u.pn) * 16;
#pragma unroll
                for (int j = 0; j < 16; j += 4) {
                    unsigned e4[4];
#pragma unroll
                    for (int q = 0; q < 4; ++q) { const int ab = 255 - (int)(best[j + q] & 255u); const unsigned eid = (unsigned)((127 - (int)(K1[ab >> 4] & 127u)) * PNK + (127 - (int)(K2[ab & 15] & 127u)));
                        e4[q] = eid | (pk2(0.f, e[j + q] * ies) & 0xffff0000u); }
                    *(u32x4*)(io + j) = (u32x4){e4[0], e4[1], e4[2], e4[3]};
                }
            }
            __syncthreads();
        }
    }
};
}

__device__ __forceinline__ float wave_total(float v) {
    v += dppf<XOR1>(v); v += dppf<XOR2>(v); v += dppf<XOR7>(v); v += dppf<ROR8>(v);
    v += __builtin_bit_cast(float, __builtin_amdgcn_update_dpp(0, __builtin_bit_cast(int, v), 0x142, 0xa, 0xf, false));
    v += __builtin_bit_cast(float, __builtin_amdgcn_update_dpp(0, __builtin_bit_cast(int, v), 0x143, 0xc, 0xf, false));
    return __builtin_bit_cast(float, __builtin_amdgcn_readlane(__builtin_bit_cast(int, v), 63));
}
typedef int i32x8 __attribute__((ext_vector_type(8)));
__device__ __forceinline__ void peer_expert_phase(Frame& F, int layer, int nrows, const float* mod, float oscale, int fuse_next, int idmask = 0x3fff) {
    const bf16_t* H = (const bf16_t*)(FWS(F) + WS_H);
    const unsigned char* PU8 = FWS(F) + WS_PU + (size_t)layer * (16 * MiB);
    const f32x2* SC2 = (const f32x2*)(FWS(F) + WS_PSC) + (size_t)layer * PN;
    const unsigned* IDX = (const unsigned*)(FWS(F) + WS_IDX);
    bf16_t* XR = (bf16_t*)(FWS(F) + WS_XR);
    const int lane = F.lane, gw = F.bid * NWAVES + F.wave, NGW = F.G * NWAVES;
    const int mcol = lane & 15, g = lane >> 4;
    LAS unsigned char* wl = F.lds + F.wave * 17408;
    { unsigned z = 0u; asm volatile("" : "+v"(z)); *(LAS u32x2*)(wl + 8192 + 8 * lane) = (u32x2){z, z}; }
    LAS unsigned char* wlu = wl + 8704; const unsigned urd = (unsigned)(mcol * 528 + g * 16);
    const unsigned lane8 = 8u * (unsigned)lane;
    const int ntw = gw < nrows ? (nrows - gw + NGW - 1) / NGW : 0;
    unsigned s0[4], s1[4]; float invs[4];
    u32x4 hx[4][2]; unsigned r0[4], r1[4];
    float su0, gv0; u32x2 uq[16], vq[16];
#define PEER_HEAD_LOADS(gb, ntg) do { _Pragma("unroll") for (int t = 0; t < 4; ++t) { const int row_ = gw + ((gb) + (t < (ntg) ? t : 0)) * NGW; \
            hx[t][0] = *(const u32x4*)(H + (size_t)row_ * D + 16 * lane); hx[t][1] = *(const u32x4*)(H + (size_t)row_ * D + 16 * lane + 8); \
            r0[t] = IDX[(size_t)row_ * 128 + lane]; r1[t] = IDX[(size_t)row_ * 128 + 64 + lane]; } } while (0)
#define PEER_SORT(t) do             { \
                const int q0 = (int)((r0[t] & 0xffffu) >> 10), q1 = (int)((r1[t] & 0xffffu) >> 10); \
                int base = 0, p0 = 0, p1 = 0; \
                _Pragma("unroll") \
                for (int r = 0; r < 16; ++r) { \
                    const unsigned long long b0 = __builtin_amdgcn_ballot_w64(q0 == r), b1 = __builtin_amdgcn_ballot_w64(q1 == r); \
                    const int c0 = __builtin_popcountll(b0), c1 = __builtin_popcountll(b1); \
                    const int m0 = (int)__builtin_amdgcn_mbcnt_hi((unsigned)(b0 >> 32), __builtin_amdgcn_mbcnt_lo((unsigned)b0, 0u)), m1 = (int)__builtin_amdgcn_mbcnt_hi((unsigned)(b1 >> 32), __builtin_amdgcn_mbcnt_lo((unsigned)b1, 0u)); \
                    if (q0 == r) p0 = base + m0; \
                    if (q1 == r) p1 = base + c0 + m1; \
                    base += c0 + c1; \
                } \
                LAS unsigned* tmp = (LAS unsigned*)wlu; \
                tmp[p0] = r0[t]; tmp[p1] = r1[t]; \
                asm volatile("s_waitcnt lgkmcnt(0)" ::: "memory"); \
                s0[t] = tmp[lane]; s1[t] = tmp[64 + lane]; \
                asm volatile("s_waitcnt lgkmcnt(0)" ::: "memory"); \
            } while (0)
    auto heads = [&](int nt) __attribute__((always_inline)) {
        { const int t = 0; PEER_SORT(t); }
        { const unsigned pwc = (unsigned)__shfl((int)s0[0], mcol);
          const int id0 = (int)(pwc & 0xffffu) & idmask; const f32x2 s2 = SC2[id0]; su0 = s2.x; gv0 = bfhi(pwc) * s2.y;
#pragma unroll
          for (int k = 0; k < 16; ++k) { const int e = __builtin_amdgcn_readlane((int)pwc, k) & 0xffff & idmask; unsigned v8 = lane8; asm volatile("" : "+v"(v8));
              uq[k] = *(const u32x2*)(PU8 + (size_t)e * 1024 + v8); }
#pragma unroll
          for (int k = 0; k < 16; ++k) { const int e = __builtin_amdgcn_readlane((int)pwc, k) & 0xffff & idmask; unsigned v8 = lane8; asm volatile("" : "+v"(v8));
              vq[k] = *(const u32x2*)(PU8 + (size_t)e * 1024 + 512 + v8); } }
#pragma unroll
        for (int t = 0; t < 4; ++t) if (t < nt) {
            float xf[16];
            { float tt[8]; unpack8(hx[t][0], tt);
#pragma unroll
              for (int j = 0; j < 8; ++j) xf[j] = tt[j];
              unpack8(hx[t][1], tt);
#pragma unroll
              for (int j = 0; j < 8; ++j) xf[8 + j] = tt[j]; }
            float mx = 0.f;
#pragma unroll
            for (int j = 0; j < 16; ++j) mx = fmaxf(mx, fabsf(xf[j]));
            mx = wave_max(mx);
            int se = 255 - (int)((__builtin_bit_cast(unsigned, mx) >> 23) & 0xffu); se = se > 250 ? 250 : se;
            const float xs = __builtin_bit_cast(float, (unsigned)se << 23); invs[t] = __builtin_bit_cast(float, (unsigned)(254 - se) << 23);
            {
                float y[16];
#pragma unroll
                for (int j = 0; j < 16; ++j) y[j] = xf[j] * xs;
#pragma unroll
                for (int st = 0; st < 4; ++st) {
                    unsigned w0 = 0u, w1 = 0u;
                    w0 = __builtin_amdgcn_cvt_scalef32_pk_fp4_f32(w0, y[0], y[1], 1.0f, 0); w0 = __builtin_amdgcn_cvt_scalef32_pk_fp4_f32(w0, y[2], y[3], 1.0f, 1);
                    w0 = __builtin_amdgcn_cvt_scalef32_pk_fp4_f32(w0, y[4], y[5], 1.0f, 2); w0 = __builtin_amdgcn_cvt_scalef32_pk_fp4_f32(w0, y[6], y[7], 1.0f, 3);
                    w1 = __builtin_amdgcn_cvt_scalef32_pk_fp4_f32(w1, y[8], y[9], 1.0f, 0); w1 = __builtin_amdgcn_cvt_scalef32_pk_fp4_f32(w1, y[10], y[11], 1.0f, 1);
                    w1 = __builtin_amdgcn_cvt_scalef32_pk_fp4_f32(w1, y[12], y[13], 1.0f, 2); w1 = __builtin_amdgcn_cvt_scalef32_pk_fp4_f32(w1, y[14], y[15], 1.0f, 3);
                    *(LAS u32x2*)(wl + t * 2048 + st * 512 + 8 * lane) = (u32x2){w0, w1};
                    if (st < 3) {
                        f32x2 d;
                        d = __builtin_amdgcn_cvt_scalef32_pk_f32_fp4(w0, 1.0f, 0); y[0] = (y[0] - d.x) * 8.0f; y[1] = (y[1] - d.y) * 8.0f;
                        d = __builtin_amdgcn_cvt_scalef32_pk_f32_fp4(w0, 1.0f, 1); y[2] = (y[2] - d.x) * 8.0f; y[3] = (y[3] - d.y) * 8.0f;
                        d = __builtin_amdgcn_cvt_scalef32_pk_f32_fp4(w0, 1.0f, 2); y[4] = (y[4] - d.x) * 8.0f; y[5] = (y[5] - d.y) * 8.0f;
                        d = __builtin_amdgcn_cvt_scalef32_pk_f32_fp4(w0, 1.0f, 3); y[6] = (y[6] - d.x) * 8.0f; y[7] = (y[7] - d.y) * 8.0f;
                        d = __builtin_amdgcn_cvt_scalef32_pk_f32_fp4(w1, 1.0f, 0); y[8] = (y[8] - d.x) * 8.0f; y[9] = (y[9] - d.y) * 8.0f;
                        d = __builtin_amdgcn_cvt_scalef32_pk_f32_fp4(w1, 1.0f, 1); y[10] = (y[10] - d.x) * 8.0f; y[11] = (y[11] - d.y) * 8.0f;
                        d = __builtin_amdgcn_cvt_scalef32_pk_f32_fp4(w1, 1.0f, 2); y[12] = (y[12] - d.x) * 8.0f; y[13] = (y[13] - d.y) * 8.0f;
                        d = __builtin_amdgcn_cvt_scalef32_pk_f32_fp4(w1, 1.0f, 3); y[14] = (y[14] - d.x) * 8.0f; y[15] = (y[15] - d.y) * 8.0f;
                    }
                }
            }
            if (t > 0) PEER_SORT(t);
        } else { s0[t] = 0u; s1[t] = 0u; invs[t] = 0.f; }
    };
    if (ntw > 0) { const int nt0 = ntw < 4 ? ntw : 4; PEER_HEAD_LOADS(0, nt0); heads(nt0); }
    for (int g0 = 0; g0 < ntw; g0 += 4) {
        const int nt = ntw - g0 < 4 ? ntw - g0 : 4, ntn = ntw - g0 - 4 < 4 ? ntw - g0 - 4 : 4;
        f32x2 o2[4][8];
#pragma unroll
        for (int t = 0; t < 4; ++t)
#pragma unroll
            for (int j = 0; j < 8; ++j) o2[t][j] = (f32x2){0.f, 0.f};
#pragma nounroll
        for (int b = 0; b < 8; ++b) {
#pragma unroll
            for (int t = 0; t < 4; ++t) if (t < nt) {
                unsigned pwn;
                { const bool wrap = (t + 1 >= nt); const int bn = wrap ? (b + 1 < 8 ? b + 1 : b) : b;
                  const unsigned a0 = wrap ? s0[0] : s0[(t + 1) & 3], a1 = wrap ? s1[0] : s1[(t + 1) & 3];
                  pwn = (unsigned)__shfl((int)((bn & 4) ? a1 : a0), 16 * (bn & 3) + mcol); }
#pragma unroll
                for (int k = 0; k < 16; ++k) *(LAS u32x2*)(wlu + k * 528 + lane8) = uq[k];
                f32x4 c = (f32x4){0.f, 0.f, 0.f, 0.f};
                const unsigned ard = mcol < 4 ? (unsigned)(t * 2048 + mcol * 512 + g * 16) : 8192u;
#pragma unroll
                for (int kb = 0; kb < 8; ++kb) { const u32x4 xa = *(const LAS u32x4*)(wl + ard + kb * 64), ub = *(const LAS u32x4*)(wlu + urd + kb * 64);
                    c = __builtin_amdgcn_mfma_scale_f32_16x16x128_f8f6f4((i32x8){(int)xa.x, (int)xa.y, (int)xa.z, (int)xa.w, 0, 0, 0, 0}, (i32x8){(int)ub.x, (int)ub.y, (int)ub.z, (int)ub.w, 0, 0, 0, 0}, c,
                                                                         4  , 4  , 0, 0x7f7f7f7f, 0, 0x7f7f7f7f); }
                const float T = (c[0] + c[1] * 0.125f) + (c[2] * 0.015625f + c[3] * 0.001953125f);
                const int id1 = (int)(pwn & 0xffffu) & idmask;
                const f32x2 s21 = SC2[id1];
#pragma unroll
                for (int k = 0; k < 16; ++k) { const int e1 = __builtin_amdgcn_readlane((int)pwn, k) & 0xffff & idmask; unsigned v8 = lane8; asm volatile("" : "+v"(v8));
                    uq[k] = *(const u32x2*)(PU8 + (size_t)e1 * 1024 + v8); }
                const float wv = gv0 * gelu_tanh(T * (su0 * invs[t]));
#pragma unroll
                for (int k = 0; k < 16; ++k) {
                    const float w = __builtin_bit_cast(float, __builtin_amdgcn_readlane(__builtin_bit_cast(int, wv), k));
#pragma unroll
                    for (int wd = 0; wd < 2; ++wd) {
                        const unsigned wq = vq[k][wd];
                        o2[t][4 * wd] += __builtin_amdgcn_cvt_scalef32_pk_f32_fp4(wq, 1.0f, 0) * w; o2[t][4 * wd + 1] += __builtin_amdgcn_cvt_scalef32_pk_f32_fp4(wq, 1.0f, 1) * w;
                        o2[t][4 * wd + 2] += __builtin_amdgcn_cvt_scalef32_pk_f32_fp4(wq, 1.0f, 2) * w; o2[t][4 * wd + 3] += __builtin_amdgcn_cvt_scalef32_pk_f32_fp4(wq, 1.0f, 3) * w;
                    }
                    const int e1 = __builtin_amdgcn_readlane((int)pwn, k) & 0xffff & idmask; unsigned v8 = lane8; asm volatile("" : "+v"(v8));
                    vq[k] = *(const u32x2*)(PU8 + (size_t)e1 * 1024 + 512 + v8);
                }
#pragma unroll
                for (int j = 0; j < 8; ++j) asm volatile("" : "+v"(o2[t][j]));
                __builtin_amdgcn_sched_barrier(0);
                su0 = s21.x; gv0 = bfhi(pwn) * s21.y;
            }
        }
#pragma unroll
        for (int t = 0; t < 4; ++t) if (t < nt) {
            const int row = gw + (g0 + t) * NGW;
            float o[16];
#pragma unroll
            for (int j = 0; j < 8; ++j) { o[2 * j] = o2[t][j].x; o[2 * j + 1] = o2[t][j].y; }
            const bool isc = row >= NLAT; const int mrow = isc ? 16 : row / SEQ;
            bf16_t* xr = XR + (size_t)row * D + 16 * lane;
            const float* g2 = mod + (size_t)mrow * 6144 + 5 * 1024 + 16 * lane;
            f32x4 xn[4]; float ssq = 0.f;
            { float xo[16]; float tt[8]; unpack8(*(const u32x4*)xr, tt);
#pragma unroll
              for (int j = 0; j < 8; ++j) xo[j] = tt[j];
              unpack8(*(const u32x4*)(xr + 8), tt);
#pragma unroll
              for (int j = 0; j < 8; ++j) xo[8 + j] = tt[j];
#pragma unroll
              for (int q = 0; q < 4; ++q) { const f32x4 gg = *(const f32x4*)(g2 + 4 * q);
                  xn[q] = (f32x4){xo[4 * q], xo[4 * q + 1], xo[4 * q + 2], xo[4 * q + 3]} + gg * oscale * (f32x4){o[4 * q], o[4 * q + 1], o[4 * q + 2], o[4 * q + 3]};
                  ssq += (xn[q][0] * xn[q][0] + xn[q][1] * xn[q][1]) + (xn[q][2] * xn[q][2] + xn[q][3] * xn[q][3]); } }
            if (fuse_next != 2) {
                *(u32x4*)xr = (u32x4){pk2(xn[0][0], xn[0][1]), pk2(xn[0][2], xn[0][3]), pk2(xn[1][0], xn[1][1]), pk2(xn[1][2], xn[1][3])};
                *(u32x4*)(xr + 8) = (u32x4){pk2(xn[2][0], xn[2][1]), pk2(xn[2][2], xn[2][3]), pk2(xn[3][0], xn[3][1]), pk2(xn[3][2], xn[3][3])};
            }
            if (fuse_next != 0) {
                const float rs = rsqrtf(wave_total(ssq) * (1.f / D) + 1e-6f);
                if (fuse_next == 1) {
                    const float* gn = F.tab[I_N1G] + (size_t)(layer + 1) * D + 16 * lane; const float* shn = mod + (size_t)17 * 6144 + (size_t)mrow * 6144 + 16 * lane;
                    unsigned w[8];
#pragma unroll
                    for (int q = 0; q < 4; ++q) {
                        const f32x4 y = xn[q] * rs * *(const f32x4*)(gn + 4 * q) * (*(const f32x4*)(shn + 1024 + 4 * q) + 1.0f) + *(const f32x4*)(shn + 4 * q);
                        w[2 * q] = pk2(y[0], y[1]); w[2 * q + 1] = pk2(y[2], y[3]);
                    }
                    bf16_t* hr = (bf16_t*)(FWS(F) + WS_H) + (size_t)row * D + 16 * lane;
                    *(u32x4*)hr = (u32x4){w[0], w[1], w[2], w[3]}; *(u32x4*)(hr + 8) = (u32x4){w[4], w[5], w[6], w[7]};
                } else {
                    const float* gf = F.tab[I_FING] + 16 * lane; float* orow = FOUT(F) + (size_t)row * D + 16 * lane;
#pragma unroll
                    for (int q = 0; q < 4; ++q) *(f32x4*)(orow + 4 * q) = xn[q] * rs * *(const f32x4*)(gf + 4 * q);
                }
            }
        }
        if (ntn > 0) { PEER_HEAD_LOADS(g0 + 4, ntn); heads(ntn); }
    }
#undef PEER_HEAD_LOADS
#undef PEER_SORT
}

__device__ __forceinline__ void final_norm_phase(Frame& F) {
    const int gw = F.bid * NWAVES + F.wave, NGW = F.G * NWAVES; const float* g = F.tab[I_FING];
    for (int m = gw; m < NLAT; m += NGW) {
        f32x4* xr = (f32x4*)(FOUT(F) + (size_t)m * D) + F.lane;
        f32x4 v[4]; float s = 0.f;
#pragma unroll
        for (int j = 0; j < 4; ++j) { v[j] = xr[64 * j]; s += (v[j].x * v[j].x + v[j].y * v[j].y) + (v[j].z * v[j].z + v[j].w * v[j].w); }
        const float rs = rsqrtf(wave_sum(s) * (1.f / D) + 1e-6f);
#pragma unroll
        for (int j = 0; j < 4; ++j) xr[64 * j] = v[j] * rs * ((const f32x4*)g + F.lane)[64 * j];
    }
}

__global__ void __launch_bounds__(NTHR, 2) mega(Args args) {
    extern __shared__ __attribute__((aligned(16))) unsigned char lds_raw[];
    cg::grid_group grid = cg::this_grid();
    Frame F;
    F.lds = (LAS unsigned char*)lds_raw;
    F.tid = threadIdx.x; F.lane = F.tid & 63; F.wave = __builtin_amdgcn_readfirstlane(F.tid >> 6); F.G = gridDim.x; F.bid = blockIdx.x;
    F.tab = (ktab_t)__builtin_amdgcn_kernarg_segment_ptr();
    volatile LAS unsigned* xst = (volatile LAS unsigned*)(F.lds + LDS_BYTES - 64);
    if (threadIdx.x < 2) xst[threadIdx.x] = 0u;
    __syncthreads();
    const XcdBarrier xbar = xcd_barrier_post((unsigned*)(FWS(F) + WS_CTL), xst);
    const float* MOD = (const float*)(FWS(F) + WS_MOD);
    bf16_t* H = (bf16_t*)(FWS(F) + WS_H); bf16_t* Zb = (bf16_t*)(FWS(F) + WS_Z); bf16_t* Qb = (bf16_t*)(FWS(F) + WS_Q);
#define REFRESH() do { int _t = threadIdx.x; asm volatile("" : "+v"(_t)); F.tid = _t; F.lane = _t & 63; F.wave = __builtin_amdgcn_readfirstlane(_t >> 6); ktab_t _kt = F.tab; asm volatile("" : "+s"(_kt)); F.tab = _kt; } while (0)
#define GSYNC() do { xcd_barrier(xbar); REFRESH(); } while (0)
#define GSYNC_CG() do { __threadfence(); grid.sync(); REFRESH(); } while (0)

#ifndef REPMASK
#define REPMASK 0
#endif
#ifndef PROBE_IDMASK
#define PROBE_IDMASK 0x3fff
#endif
#ifndef PEER_OSCALE
#define PEER_OSCALE 1.0f
#endif
#define NREP(k) (1 + ((REPMASK >> (k)) & 1))
    for (int rep = 0; rep < NREP(0); ++rep) { p0_prologue(F);
        if (args.pad0 == 0x5eed) GSYNC_CG();
        GSYNC(); }
    for (int layer = 0; layer < 2; ++layer) {
        const bool need_ctx = layer == 0;
        const float* mod = MOD + (size_t)layer * 17 * 6144;
        const float* xl_in = F.tab[I_X]; const float* xc_in = F.tab[I_CTX];
        const int nrows2 = need_ctx ? NTOK : NLAT;
        if (layer == 0) for (int rep = 0; rep < NREP(1); ++rep) { norm_mod_phase(F, xl_in, xc_in, F.tab[I_N1G] + (size_t)layer * D, mod, 0, NTOK); GSYNC(); }
        for (int rep = 0; rep < NREP(2); ++rep) { pg8::Gemm g{H, (const bf16_t*)(FWS(F) + WS_WIN) + (size_t)layer * DINP * D, D, D, 0}; pg8::StaticOrder S; S.init(NTOK / 256, DINP / 256, F.G, F.bid);
          pg8::EpiBf16 E{Zb, DINP}; pg8::gemm_phase<pg8::EpiBf16, pg8::StaticOrder, true>(F.lds, g, S, E); GSYNC(); }
        for (int rep = 0; rep < NREP(3); ++rep) { mixer_phase(F, layer); GSYNC(); }
        for (int rep = 0; rep < NREP(4); ++rep) { rwkv_post_phase(F, layer, nrows2); GSYNC(); }
        for (int rep = 0; rep < NREP(5); ++rep) { pg8::Gemm g{H, (const bf16_t*)(FWS(F) + WS_WOUT) + (size_t)layer * D * D, D, D, 0}; pg8::StaticOrder S; S.init(nrows2 / 256, D / 256, F.G, F.bid);
          if (layer == 0) { pg8::EpiRes<false> E{xl_in, xc_in, (bf16_t*)(FWS(F) + WS_XR), mod + 2 * 1024, (rep + 1 == NREP(5)) ? 1.0f : 0.0f}; pg8::gemm_phase<pg8::EpiRes<false>, pg8::StaticOrder, true>(F.lds, g, S, E); }
          else { pg8::EpiRes<true> E{xl_in, xc_in, (bf16_t*)(FWS(F) + WS_XR), mod + 2 * 1024, (rep + 1 == NREP(5)) ? 1.0f : 0.0f}; pg8::gemm_phase<pg8::EpiRes<true>, pg8::StaticOrder, true>(F.lds, g, S, E); }
          GSYNC(); }
        for (int rep = 0; rep < NREP(6); ++rep) { norm_mod_phase_xr(F, F.tab[I_N2G] + (size_t)layer * D, mod, 3 * 1024, nrows2); GSYNC(); }
        for (int rep = 0; rep < NREP(8); ++rep) { pg8::Gemm g{H, (const bf16_t*)(FWS(F) + WS_QW) + (size_t)layer * 2048 * D, D, D, 0};   pg8::StaticOrder S; S.init(nrows2 / 256, 8, F.G, F.bid);
          pg8::EpiTopk E{(int*)(FWS(F) + WS_IDX), (float*)(FWS(F) + WS_GATE)};
          for (int i = 0;; ++i) { pg8::OneUnit O; if (!S.next(i, O.u)) break; pg8::gemm_phase<pg8::EpiTopk, pg8::OneUnit, false>(F.lds, g, O, E); }
          GSYNC(); }
        for (int rep = 0; rep < NREP(9); ++rep) { const bool lastrep = (rep + 1 == NREP(9)); peer_expert_phase(F, layer, nrows2, mod, lastrep ? PEER_OSCALE : 0.0f, lastrep ? (layer == 0 ? 1 : 2) : 0, lastrep ? 0x3fff : PROBE_IDMASK); if (layer == 0 || !lastrep) GSYNC(); }
    }
#undef GSYNC
#undef GSYNC_CG
#undef REFRESH
}

extern "C" void kernel_launch(void* const* d_in, const int* in_sizes, int n_in, void* d_out, int out_size, void* d_ws, size_t ws_size, hipStream_t stream) {
    static int grid = 0;
    if (grid == 0) {
        int dev = 0, cus = 0, per_cu = 0;
        if (n_in != 26 || out_size != NLAT * D || ws_size < WS_END) { fprintf(stderr, "kernel_launch: unexpected shapes (n_in %d, out %d, ws %zu, need %zu)\n", n_in, out_size, ws_size, (size_t)WS_END); grid = -1; return; }
        if (hipGetDevice(&dev) != hipSuccess || hipDeviceGetAttribute(&cus, hipDeviceAttributeMultiprocessorCount, dev) != hipSuccess) { grid = -1; return; }
        if (hipFuncSetAttribute((const void*)mega, hipFuncAttributeMaxDynamicSharedMemorySize, LDS_BYTES) != hipSuccess) { fprintf(stderr, "kernel_launch: hipFuncSetAttribute failed\n"); grid = -1; return; }
        if (hipOccupancyMaxActiveBlocksPerMultiprocessor(&per_cu, (const void*)mega, NTHR, LDS_BYTES) != hipSuccess || per_cu < 1) { fprintf(stderr, "kernel_launch: occupancy query says %d\n", per_cu); grid = -1; return; }
        grid = cus;
        fprintf(stderr, "kernel_launch: grid %d (per_cu %d), ws %zu\n", grid, per_cu, ws_size);
    }
    if (grid < 0) return;
    if (hipMemsetAsync((char*)d_ws + WS_CTL, 0, 16384, stream) != hipSuccess) { fprintf(stderr, "kernel_launch: memset failed\n"); return; }
    Args a{};
    for (int i = 0; i < 26; ++i) a.in[i] = (const float*)d_in[i];
    a.out = (float*)d_out; a.ws = (unsigned char*)d_ws;
    void* kargs[] = {&a};
    hipError_t e = hipLaunchCooperativeKernel((const void*)mega, dim3(grid), dim3(NTHR), kargs, LDS_BYTES, stream);
    if (e != hipSuccess) fprintf(stderr, "cooperative launch failed: %s (grid %d)\n", hipGetErrorString(e), grid);
}
```

```cpp
#define REPMASK 0
#include <hip/hip_runtime.h>
#include <hip/hip_cooperative_groups.h>
#include <cstdio>
#include <cstdint>
namespace cg = cooperative_groups;

#define LAS __attribute__((address_space(3)))
typedef unsigned short bf16_t;
typedef short bf16x8 __attribute__((ext_vector_type(8)));
typedef float f32x4 __attribute__((ext_vector_type(4)));
typedef float f32x2 __attribute__((ext_vector_type(2)));
typedef unsigned u32x4 __attribute__((ext_vector_type(4)));
typedef unsigned u32x2 __attribute__((ext_vector_type(2)));

constexpr int D = 1024, NB = 16, SEQ = 2048, CTXL = 256, NLAT = NB * SEQ, NCTX = NB * CTXL, NTOK = NLAT + NCTX;
constexpr int DIN = 3456, DINP = 3584;
constexpr int ZR = 0, ZK = 256, ZV = 512, ZW = 768, ZA = 896, ZG = 1024, ZNQ = 1152, ZNK = 1664, ZNV = 2176, ZSB = 2688, ZSC = 2944, ZSX = 3200;
constexpr int RWW = 256, NAW = 512, SCW = 256;
constexpr int PH = 8, PK = 16, PNK = 128, PDQ = 256, PN = 16384;
constexpr int NWAVES = 8, NTHR = 512;
constexpr int LDS_BYTES = 147456;

constexpr size_t MiB = 1u << 20;
constexpr size_t WS_CTL = 0, WS_MOD = 1 * MiB, WS_WUPT = 2 * MiB, WS_AUPT = 2 * MiB + 512 * 1024, WS_SUBK = 3 * MiB, WS_WIN = 5 * MiB, WS_WOUT = 19 * MiB, WS_QW = 23 * MiB;
constexpr size_t WS_PU = 31 * MiB, WS_YS = 63 * MiB, WS_H = 111 * MiB, WS_XR = 183 * MiB, WS_Z = 255 * MiB, WS_END = 507 * MiB;
constexpr size_t WS_PSC = WS_CTL + 512 * 1024;
constexpr size_t WS_Q = WS_Z, WS_IDX = WS_Z + 144 * MiB, WS_GATE = WS_Z + 162 * MiB;
static_assert(WS_Z + (size_t)NTOK * DINP * 2 <= WS_END, "ws map");
static_assert(WS_GATE + (size_t)NTOK * 128 * 4 <= WS_END, "ws map");

typedef __bf16 bf16x2_t __attribute__((ext_vector_type(2)));
__device__ __forceinline__ unsigned pk2(float lo, float hi) { const bf16x2_t v = __builtin_convertvector((f32x2){lo, hi}, bf16x2_t); return __builtin_bit_cast(unsigned, v); }
__device__ __forceinline__ unsigned f2bf(float f) { return pk2(f, 0.f) & 0xffffu; }
__device__ __forceinline__ float bflo(unsigned w) { return __builtin_bit_cast(float, w << 16); }
__device__ __forceinline__ float bfhi(unsigned w) { return __builtin_bit_cast(float, w & 0xffff0000u); }
__device__ __forceinline__ float bf2f(bf16_t h) { return __builtin_bit_cast(float, (unsigned)h << 16); }
__device__ __forceinline__ void unpack8(const u32x4 w, float (&f)[8]) { f[0] = bflo(w.x); f[1] = bfhi(w.x); f[2] = bflo(w.y); f[3] = bfhi(w.y); f[4] = bflo(w.z); f[5] = bfhi(w.z); f[6] = bflo(w.w); f[7] = bfhi(w.w); }
__device__ __forceinline__ float wave_sum(float v) {
#pragma unroll
    for (int o = 1; o < 64; o <<= 1) v += __shfl_xor(v, o);
    return v;
}
template <int CTRL> __device__ __forceinline__ float dppf(float x) { return __builtin_bit_cast(float, __builtin_amdgcn_mov_dpp(__builtin_bit_cast(int, x), CTRL, 0xf, 0xf, true)); }
constexpr int XOR1 = 0xB1, XOR2 = 0x4E, XOR7 = 0x141, ROR8 = 0x128;
__device__ __forceinline__ float sum8(float v) { v += dppf<XOR1>(v); v += dppf<XOR2>(v); v += dppf<XOR7>(v); return v; }
__device__ __forceinline__ float sum16(float v) { v = sum8(v); v += dppf<ROR8>(v); return v; }
__device__ __forceinline__ float sigmoidf_(float x) { return 1.0f / (1.0f + __expf(-x)); }
__device__ __forceinline__ float tanhf_(float x) { const float e = __expf(-2.0f * fabsf(x)); const float t = (1.0f - e) / (1.0f + e); return x < 0.f ? -t : t; }
__device__ __forceinline__ float gelu_tanh(float x) { const float u = 0.7978845608028654f * (x + 0.044715f * x * x * x); return 0.5f * x * (1.0f + tanhf_(u)); }

namespace pg8 {
constexpr int BM = 256, BK = 64, HALF = 128, HTB = HALF * BK * 2, STAGE_BYTES = 8 * HTB, NXCD = 8, WGM = 8;
__host__ __device__ __forceinline__ int lds_byte(int r, int c) { const int st = (r >> 4) * 2 + (c >> 5), rr = r & 15, cc = c & 31, ob = rr * 64 + cc * 2; return st * 1024 + (ob ^ (((ob >> 9) & 1) << 5)); }
__host__ __device__ __forceinline__ void stage_rc(int b, int& R, int& C) { const int st = b / 1024, sb = b % 1024, swz = sb ^ (((sb >> 9) & 1) << 5); R = (st >> 1) * 16 + swz / 64; C = (st & 1) * 32 + (swz % 64) / 2; }
__host__ __device__ __forceinline__ int perm32(int rho) { const int n = rho >> 4, i = rho & 15; return 8 * (i >> 2) + 4 * n + (i & 3); }
struct Unit { int pm, pn; };
struct Gemm { const bf16_t* A; const bf16_t* Bt; int lda, K, acs; };
struct StaticOrder {
    int nM, nN, nwg, G, c;
    __device__ void init(int nM_, int nN_, int G_, int c_) { nM = nM_; nN = nN_; nwg = nM * nN; G = G_; c = c_; }
    __device__ bool next(int i, Unit& u) const {
        const long L = (long)i * G + c; if (L >= nwg) return false;
        int wgid = (int)L; { const int q = nwg / NXCD, r = nwg % NXCD, xcd = wgid % NXCD, off = wgid / NXCD; wgid = (xcd < r ? xcd * (q + 1) : r * (q + 1) + (xcd - r) * q) + off; }
        const int nig = WGM * nN, gid = wgid / nig, fm = gid * WGM, gsz = (nM - fm) < WGM ? (nM - fm) : WGM;
        u.pm = fm + ((wgid % nig) % gsz); u.pn = (wgid % nig) / gsz; return true;
    }
};
struct OneUnit { Unit u; __device__ bool next(int i, Unit& o) const { if (i != 0) return false; o = u; return true; } };

__device__ __forceinline__ unsigned cvt_pk_bf16(float lo, float hi) { unsigned r; asm volatile("v_cvt_pk_bf16_f32 %0, %1, %2" : "=v"(r) : "v"(lo), "v"(hi)); return r; }

struct EpiBf16 {
    static constexpr bool PERM = true, AFTER_DRAIN = false;
    bf16_t* O; int ldc;
    __device__ __forceinline__ void operator()(const f32x4 (&acc)[2][2][4][2], const Unit& u, int wr, int wc, int fr, int fq) const {
        const int row0 = u.pm * BM + wr * 64 + fr; const int col0 = u.pn * BM + wc * 32 + 8 * fq;
#pragma unroll
        for (int ai = 0; ai < 2; ++ai)
#pragma unroll
            for (int m = 0; m < 4; ++m) { bf16_t* rowp = O + (size_t)(row0 + ai * HALF + m * 16) * ldc + col0;
#pragma unroll
                for (int bj = 0; bj < 2; ++bj) { const f32x4 v0 = acc[ai][bj][m][0], v1 = acc[ai][bj][m][1];
                    u32x4 w; w.x = cvt_pk_bf16(v0[0], v0[1]); w.y = cvt_pk_bf16(v0[2], v0[3]); w.z = cvt_pk_bf16(v1[0], v1[1]); w.w = cvt_pk_bf16(v1[2], v1[3]);
                    *(u32x4*)(rowp + bj * HALF) = w; } }
    }
};
template <bool BASE_BF16> struct EpiRes {
    static constexpr bool PERM = true, AFTER_DRAIN = false;
    const float* base_l; const float* base_c; bf16_t* XR; const float* gate; float oscale;
    __device__ __forceinline__ void operator()(const f32x4 (&acc)[2][2][4][2], const Unit& u, int wr, int wc, int fr, int fq) const {
        const int rowt = u.pm * BM; const bool isc = rowt >= NLAT;
        const int mrow = isc ? 16 : rowt / SEQ;
        const float* base = isc ? base_c - (size_t)NLAT * D : base_l;
        const int row0 = rowt + wr * 64 + fr, col0 = u.pn * BM + wc * 32 + 8 * fq;
        f32x4 gv[2][2];
#pragma unroll
        for (int bj = 0; bj < 2; ++bj)
#pragma unroll
            for (int n = 0; n < 2; ++n) gv[bj][n] = *(const f32x4*)(gate + (size_t)mrow * 6144 + col0 + bj * HALF + n * 4) * oscale;
#pragma unroll
        for (int ai = 0; ai < 2; ++ai)
#pragma unroll
            for (int m = 0; m < 4; ++m) { const size_t off = (size_t)(row0 + ai * HALF + m * 16) * D + col0;
#pragma unroll
                for (int bj = 0; bj < 2; ++bj) { f32x4 b0, b1;
                    if (BASE_BF16) { const u32x4 w = *(const u32x4*)(XR + off + bj * HALF); b0 = (f32x4){bflo(w.x), bfhi(w.x), bflo(w.y), bfhi(w.y)}; b1 = (f32x4){bflo(w.z), bfhi(w.z), bflo(w.w), bfhi(w.w)}; }
                    else { b0 = *(const f32x4*)(base + off + bj * HALF); b1 = *(const f32x4*)(base + off + bj * HALF + 4); }
                    const f32x4 x0 = b0 + gv[bj][0] * acc[ai][bj][m][0], x1 = b1 + gv[bj][1] * acc[ai][bj][m][1];
                    *(u32x4*)(XR + off + bj * HALF) = (u32x4){pk2(x0[0], x0[1]), pk2(x0[2], x0[3]), pk2(x1[0], x1[1]), pk2(x1[2], x1[3])}; }
                asm volatile("" ::: "memory"); }
    }
};

template <class Epi, class Sched, bool ALIGN_EPI = false>
__device__ __forceinline__ void gemm_phase(LAS unsigned char* lds, const Gemm g, const Sched& S, const Epi& E) {
    int tid = threadIdx.x; asm volatile("" : "+v"(tid));
    const int wid = __builtin_amdgcn_readfirstlane(tid >> 6), lane = tid & 63, wr = wid >> 2, wc = wid & 3, fr = lane & 15, fq = lane >> 4;
    const int K = g.K, nt = K / BK;
    unsigned voffA[2], voffB[2];
#pragma unroll
    for (int i = 0; i < 2; ++i) { int R, C; stage_rc(tid * 16 + i * 8192, R, C); const int Rb = Epi::PERM ? ((R & ~31) + perm32(R & 31)) : R;
        voffA[i] = (unsigned)(R * g.lda + C) * 2u; voffB[i] = (unsigned)(Rb * K + C) * 2u; }
    const size_t kstep = (size_t)(BK * 2);
    const size_t hA = (size_t)HALF * g.lda * 2, hB = (size_t)HALF * K * 2;
    const size_t tA = 2 * hA, tB = 2 * hB;
    const unsigned ldsw = (unsigned)wid * 1024u;
    const int aoff = lds_byte(wr * 64 + fr, fq * 8), boff = lds_byte(wc * 32 + fr, fq * 8);
#define PG8_SA(b, h) (((b) * 2 + (h)) * HTB)
#define PG8_SB(b, h) ((4 + (b) * 2 + (h)) * HTB)
#define PG8_STAGE(bufoff, gbase, voff) do { _Pragma("unroll") for (int _i = 0; _i < 2; ++_i) { unsigned _vo = (voff)[_i]; asm volatile("" : "+v"(_vo)); \
        __builtin_amdgcn_global_load_lds((const unsigned*)((const char*)(gbase) + _vo), (LAS unsigned*)(lds + (bufoff) + ldsw + _i * 8192), 16, 0, 0); } } while (0)
#define PG8_LDA(dst, b, h) do { _Pragma("unroll") for (int m = 0; m < 4; ++m) _Pragma("unroll") for (int k = 0; k < 2; ++k) dst[m][k] = *(const LAS bf16x8*)(lds + PG8_SA(b, h) + aoff + m * 2048 + k * 1024); } while (0)
#define PG8_LDB(dst, b, h) do { _Pragma("unroll") for (int n = 0; n < 2; ++n) _Pragma("unroll") for (int k = 0; k < 2; ++k) dst[n][k] = *(const LAS bf16x8*)(lds + PG8_SB(b, h) + boff + n * 2048 + k * 1024); } while (0)
#define PG8_MMA(ai, bj, At, Bt) do { __builtin_amdgcn_s_setprio(1); _Pragma("unroll") for (int m = 0; m < 4; ++m) _Pragma("unroll") for (int n = 0; n < 2; ++n) _Pragma("unroll") for (int k = 0; k < 2; ++k) \
        acc[ai][bj][m][n] = __builtin_amdgcn_mfma_f32_16x16x32_bf16(Bt[n][k], At[m][k], acc[ai][bj][m][n], 0, 0, 0); __builtin_amdgcn_s_setprio(0); } while (0)
#define PG8_WAIT_V(n) asm volatile("s_waitcnt vmcnt(" #n ")" ::: "memory")
#define PG8_WAIT_L(n) asm volatile("s_waitcnt lgkmcnt(" #n ")" ::: "memory")
#define PG8_BAR __builtin_amdgcn_s_barrier()
#define PG8_SCHED __builtin_amdgcn_sched_barrier(0)
    Unit cur, nxt; int ui = 0;
    if (!S.next(0, cur)) return;
    f32x4 acc[2][2][4][2];
#pragma unroll
    for (int a = 0; a < 2; ++a)
#pragma unroll
        for (int b = 0; b < 2; ++b)
#pragma unroll
            for (int m = 0; m < 4; ++m)
#pragma unroll
                for (int n = 0; n < 2; ++n) acc[a][b][m][n] = (f32x4){0.f, 0.f, 0.f, 0.f};
    bf16x8 At[4][2], B0[2][2], B1[2][2];
    const char* cA = (const char*)g.A + (size_t)cur.pm * tA + (size_t)cur.pn * g.acs * 2; const char* cB = (const char*)g.Bt + (size_t)cur.pn * tB;
    PG8_STAGE(PG8_SB(0, 0), cB, voffB); PG8_STAGE(PG8_SB(0, 1), cB + hB, voffB); PG8_STAGE(PG8_SA(0, 0), cA, voffA); PG8_STAGE(PG8_SA(0, 1), cA + hA, voffA);
    if (wr == 1) PG8_BAR;
    PG8_WAIT_V(2); PG8_BAR;
    PG8_STAGE(PG8_SB(1, 0), cB + kstep, voffB); PG8_STAGE(PG8_SA(1, 0), cA + kstep, voffA); PG8_STAGE(PG8_SB(1, 1), cB + hB + kstep, voffB);
    PG8_WAIT_V(6); PG8_BAR;
    for (;;) {
        const bool has_next = S.next(ui + 1, nxt);
        const char* nA = has_next ? (const char*)g.A + (size_t)nxt.pm * tA + (size_t)nxt.pn * g.acs * 2 : cA; const char* nB = has_next ? (const char*)g.Bt + (size_t)nxt.pn * tB : cB;
        for (int t = 0; t < nt; t += 2) {
            const bool last = (t == nt - 2);
            const char* a1 = cA + (size_t)(t + 1) * kstep;
            const char* a2 = last ? nA : cA + (size_t)(t + 2) * kstep; const char* b2 = last ? nB : cB + (size_t)(t + 2) * kstep;
            const char* a3 = a2 + kstep; const char* b3 = b2 + kstep;
            PG8_LDB(B0, 0, 0); PG8_LDB(B1, 0, 1); PG8_SCHED; PG8_LDA(At, 0, 0); PG8_STAGE(PG8_SA(1, 1), a1 + hA, voffA);
            PG8_WAIT_V(8); PG8_WAIT_L(0); PG8_BAR; PG8_MMA(0, 0, At, B0); PG8_MMA(0, 1, At, B1); PG8_BAR; PG8_SCHED;
            PG8_LDA(At, 0, 1); PG8_STAGE(PG8_SB(0, 0), b2, voffB); PG8_STAGE(PG8_SB(0, 1), b2 + hB, voffB); PG8_STAGE(PG8_SA(0, 0), a2, voffA);
            PG8_WAIT_V(8); PG8_WAIT_L(0); PG8_BAR; PG8_MMA(1, 0, At, B0); PG8_MMA(1, 1, At, B1); PG8_BAR; PG8_SCHED;
            PG8_LDB(B0, 1, 0); PG8_LDB(B1, 1, 1); PG8_SCHED; PG8_LDA(At, 1, 0); PG8_STAGE(PG8_SA(0, 1), a2 + hA, voffA);
            PG8_WAIT_V(8); PG8_WAIT_L(0); PG8_BAR; PG8_MMA(0, 0, At, B0); PG8_MMA(0, 1, At, B1); PG8_BAR; PG8_SCHED;
            PG8_LDA(At, 1, 1); PG8_STAGE(PG8_SB(1, 0), b3, voffB); PG8_STAGE(PG8_SB(1, 1), b3 + hB, voffB); PG8_STAGE(PG8_SA(1, 0), a3, voffA);
            PG8_WAIT_V(8); PG8_WAIT_L(0); PG8_BAR; PG8_MMA(1, 0, At, B0); PG8_MMA(1, 1, At, B1); PG8_BAR; PG8_SCHED;
        }
        if constexpr (ALIGN_EPI) { if (wr == 0) PG8_BAR; }
        if constexpr (!Epi::AFTER_DRAIN) { E(acc, cur, wr, wc, fr, fq); }
        if (!has_next) break;
#pragma unroll
        for (int a = 0; a < 2; ++a)
#pragma unroll
            for (int b = 0; b < 2; ++b)
#pragma unroll
                for (int m = 0; m < 4; ++m)
#pragma unroll
                    for (int n = 0; n < 2; ++n) acc[a][b][m][n] = (f32x4){0.f, 0.f, 0.f, 0.f};
        cur = nxt; cA = nA; cB = nB; ++ui;
        if constexpr (ALIGN_EPI) { if (wr == 1) PG8_BAR; }
    }
    PG8_WAIT_V(0);
    if constexpr (!ALIGN_EPI) { if (wr == 0) PG8_BAR; }
    PG8_BAR;
    if constexpr (Epi::AFTER_DRAIN) { E.fused(acc, cur, wr, wc, fr, fq, lds, wid, lane); }
#undef PG8_SA
#undef PG8_SB
#undef PG8_STAGE
#undef PG8_LDA
#undef PG8_LDB
#undef PG8_MMA
#undef PG8_WAIT_V
#undef PG8_WAIT_L
#undef PG8_BAR
#undef PG8_SCHED
}
}
struct Args { const float* in[26]; float* out; unsigned char* ws; int pad0, pad1; };
typedef const float* fptr_t;
typedef const __attribute__((address_space(4))) fptr_t* ktab_t;
struct Frame {
    LAS unsigned char* lds;
    int tid, lane, wave, G, bid;
    ktab_t tab;
};
#define FWS(F) ((unsigned char*)(F).tab[27])
#define FOUT(F) ((float*)(F).tab[26])

#define XB_TMO      128
#define XB_XCNT(j)  (256  + 64 * (j))
#define XB_XSUB(j)  (1280 + 64 * (j))
#define XB_XGEN(j)  (2304 + 64 * (j))
#define XB_TOP      3328
#define XB_TOPGEN   3392
#define XCD_BAR_WORDS 3456
#define XB_SPIN_CAP (1u << 22)
__device__ __forceinline__ unsigned xb_ld(unsigned* p)              { return __hip_atomic_load(p, __ATOMIC_RELAXED, __HIP_MEMORY_SCOPE_AGENT); }
__device__ __forceinline__ unsigned xb_add(unsigned* p, unsigned v) { return __hip_atomic_fetch_add(p, v, __ATOMIC_RELAXED, __HIP_MEMORY_SCOPE_AGENT); }
__device__ __forceinline__ unsigned xb_xcc_id() { return (unsigned)__builtin_amdgcn_s_getreg((3 << 11) | 20) & 0xFu; }
#define XB_SPIN(cond, bar) do { unsigned _sp = 0; while (cond) { __builtin_amdgcn_s_sleep(1); \
    if ((++_sp & 255u) == 0u) { if (xb_ld(&(bar)[XB_TMO])) break; if (_sp > XB_SPIN_CAP) { atomicAdd(&(bar)[XB_TMO], 1u); break; } } } } while (0)
struct XcdBarrier { unsigned* bar; unsigned x; volatile LAS unsigned* st; };
__device__ __forceinline__ XcdBarrier xcd_barrier_post(unsigned* bar, volatile LAS unsigned* st) {
    XcdBarrier b; b.bar = bar; b.x = xb_xcc_id(); b.st = st;
    if (threadIdx.x == 0) (void)xb_add(&bar[XB_XCNT(b.x)], 1u);
    return b;
}
__device__ __forceinline__ void xcd_barrier_complete(unsigned* bar, unsigned x, unsigned& nloc, unsigned& nx) {
    const unsigned G = gridDim.x * gridDim.y * gridDim.z;
    unsigned sum, cnt, mine, sp = 0u;
    for (;;) {
        sum = 0u; cnt = 0u; mine = 0u;
#pragma unroll
        for (unsigned j = 0; j < 16; ++j) { const unsigned c = xb_ld(&bar[XB_XCNT(j)]); sum += c; cnt += (c > 0u) ? 1u : 0u; mine = (j == x) ? c : mine; }
        if (sum == G) break;
        __builtin_amdgcn_s_sleep(1);
        if ((++sp & 255u) == 0u) { if (xb_ld(&bar[XB_TMO])) break; if (sp > XB_SPIN_CAP) { atomicAdd(&bar[XB_TMO], 1u); break; } }
    }
    nloc = mine > 0u ? mine : 1u; nx = cnt > 0u ? cnt : 1u;
}
__device__ __forceinline__ void xcd_barrier(const XcdBarrier& b) {
    asm volatile("s_waitcnt vmcnt(0)" ::: "memory");
    __syncthreads();
    if (threadIdx.x == 0) {
        unsigned* bar = b.bar;
        __builtin_amdgcn_s_waitcnt(0);
        unsigned nloc = b.st[0], nx = b.st[1];
        if (nloc == 0u) { xcd_barrier_complete(bar, b.x, nloc, nx); b.st[0] = nloc; b.st[1] = nx; }
        const unsigned old = xb_add(&bar[XB_XSUB(b.x)], 1u);
        const unsigned gen = old / nloc;
        if (old + 1u == (gen + 1u) * nloc) {
            __builtin_amdgcn_fence(__ATOMIC_RELEASE, "agent");
            asm volatile("s_waitcnt vmcnt(0)" ::: "memory");
            const unsigned og = xb_add(&bar[XB_TOP], 1u);
            const unsigned tg = og / nx;
            if (og + 1u == (tg + 1u) * nx) xb_add(&bar[XB_TOPGEN], 1u);
            else XB_SPIN(xb_ld(&bar[XB_TOPGEN]) == tg, bar);
            __builtin_amdgcn_fence(__ATOMIC_ACQUIRE, "agent");
            xb_add(&bar[XB_XGEN(b.x)], 1u);
            asm volatile("s_waitcnt vmcnt(0)" ::: "memory");
        } else {
            XB_SPIN(xb_ld(&bar[XB_XGEN(b.x)]) == gen, bar);
            __builtin_amdgcn_fence(__ATOMIC_ACQUIRE, "agent");
            asm volatile("s_waitcnt vmcnt(0)" ::: "memory");
        }
    }
    __syncthreads();
}

enum { I_X = 0, I_C, I_CTX, I_CCTX, I_ADAW, I_ADAB, I_N1G, I_N2G, I_WIN, I_RW0, I_RWUP, I_RA0, I_RAUP, I_RGUP, I_RKK, I_RKA, I_RRK, I_RLNX, I_RPB, I_SCW, I_WOUT, I_PQW, I_PSK, I_PU, I_PV, I_FING };

__device__ __forceinline__ void p0_transpose_item(const float* W, int K, int N, bf16_t* WT, LAS float* scr, int item, int lane) {
    const int nblk = N / 32, kb = item / nblk, nb = item % nblk, k0 = 64 * kb, n0 = 32 * nb;
#pragma unroll 8
    for (int i = 0; i < 32; ++i) { const int kk = 2 * i + (lane >> 5); scr[kk * 33 + (lane & 31)] = W[(size_t)(k0 + kk) * N + n0 + (lane & 31)]; }
    asm volatile("s_waitcnt lgkmcnt(0)" ::: "memory");
    const int c = lane & 7;
#pragma unroll
    for (int j = 0; j < 4; ++j) { const int n = (lane >> 3) + 8 * j; const LAS float* s = scr + (8 * c) * 33 + n;
        u32x4 o; o.x = pk2(s[0 * 33], s[1 * 33]); o.y = pk2(s[2 * 33], s[3 * 33]); o.z = pk2(s[4 * 33], s[5 * 33]); o.w = pk2(s[6 * 33], s[7 * 33]);
        *(u32x4*)(WT + (size_t)(n0 + n) * K + k0 + 8 * c) = o; }
    asm volatile("s_waitcnt lgkmcnt(0)" ::: "memory");
}

__device__ __forceinline__ void cvt_stream(Frame& F, const float* src, bf16_t* dst, size_t n) {
    const size_t nv = n / 8; const size_t gt = (size_t)F.bid * NTHR + F.tid, GT = (size_t)F.G * NTHR;
    for (size_t i = gt; i < nv; i += GT) {
        const f32x4 a = *(const f32x4*)(src + i * 8), b = *(const f32x4*)(src + i * 8 + 4);
        u32x4 o; o.x = pk2(a[0], a[1]); o.y = pk2(a[2], a[3]); o.z = pk2(b[0], b[1]); o.w = pk2(b[2], b[3]);
        *(u32x4*)(dst + i * 8) = o;
    }
}

__device__ __forceinline__ float wave_max(float v) {
    v = fmaxf(v, dppf<XOR1>(v)); v = fmaxf(v, dppf<XOR2>(v)); v = fmaxf(v, dppf<XOR7>(v)); v = fmaxf(v, dppf<ROR8>(v));
    v = fmaxf(v, __shfl_xor(v, 16)); v = fmaxf(v, __shfl_xor(v, 32)); return v;
}
__device__ __forceinline__ void convert_peer_tables(Frame& F, int g_begin, int g_end, int widx, int wcount) {
    const int lane = F.lane;
    for (int g4 = g_begin + widx; g4 < g_end; g4 += wcount) {
        const int r0 = 4 * g4, tb = r0 / PN, e0 = r0 % PN, layer = tb >> 1;
        const float* src = ((tb & 1) ? F.tab[I_PV] : F.tab[I_PU]) + ((size_t)layer * PN + e0) * D + 16 * lane;
        f32x4 v[4][4];
#pragma unroll
        for (int rr = 0; rr < 4; ++rr)
#pragma unroll
            for (int j = 0; j < 4; ++j) v[rr][j] = *(const f32x4*)(src + (size_t)rr * D + 4 * j);
#pragma unroll
        for (int rr = 0; rr < 4; ++rr) {
            float mx = 0.f;
#pragma unroll
            for (int j = 0; j < 4; ++j) mx = fmaxf(mx, fmaxf(fmaxf(fabsf(v[rr][j][0]), fabsf(v[rr][j][1])), fmaxf(fabsf(v[rr][j][2]), fabsf(v[rr][j][3]))));
            mx = wave_max(mx);
            const float sc = mx > 0.f ? mx * (1.0f / 6.0f) : 1.0f, inv = 1.0f / sc;
            unsigned w0 = 0u, w1 = 0u;
            w0 = __builtin_amdgcn_cvt_scalef32_pk_fp4_f32(w0, v[rr][0][0] * inv, v[rr][0][1] * inv, 1.0f, 0); w0 = __builtin_amdgcn_cvt_scalef32_pk_fp4_f32(w0, v[rr][0][2] * inv, v[rr][0][3] * inv, 1.0f, 1);
            w0 = __builtin_amdgcn_cvt_scalef32_pk_fp4_f32(w0, v[rr][1][0] * inv, v[rr][1][1] * inv, 1.0f, 2); w0 = __builtin_amdgcn_cvt_scalef32_pk_fp4_f32(w0, v[rr][1][2] * inv, v[rr][1][3] * inv, 1.0f, 3);
            w1 = __builtin_amdgcn_cvt_scalef32_pk_fp4_f32(w1, v[rr][2][0] * inv, v[rr][2][1] * inv, 1.0f, 0); w1 = __builtin_amdgcn_cvt_scalef32_pk_fp4_f32(w1, v[rr][2][2] * inv, v[rr][2][3] * inv, 1.0f, 1);
            w1 = __builtin_amdgcn_cvt_scalef32_pk_fp4_f32(w1, v[rr][3][0] * inv, v[rr][3][1] * inv, 1.0f, 2); w1 = __builtin_amdgcn_cvt_scalef32_pk_fp4_f32(w1, v[rr][3][2] * inv, v[rr][3][3] * inv, 1.0f, 3);
            *(u32x2*)(FWS(F) + WS_PU + (size_t)layer * (16 * MiB) + (size_t)(e0 + rr) * 1024 + (tb & 1) * 512 + 8 * lane) = (u32x2){w0, w1};
            if (lane == 0) ((float*)(FWS(F) + WS_PSC))[((size_t)layer * PN + e0 + rr) * 2 + (tb & 1)] = sc;
        }
    }
}

__device__ __forceinline__ void p0_prologue(Frame& F) {
    {
        LAS float* scr = (LAS float*)(F.lds + F.wave * 16384);
        const int gw = F.bid * NWAVES + F.wave, NGW = F.G * NWAVES;
        constexpr int I_IN = (D / 64) * (DIN / 32), I_OUT = (D / 64) * (D / 32);
        constexpr int PER_L = I_IN + I_OUT;
        for (int it = gw; it < 2 * PER_L; it += NGW) {
            const int l = it / PER_L; int r = it % PER_L;
            if (r < I_IN) { p0_transpose_item(F.tab[I_WIN] + (size_t)l * D * DIN, D, DIN, (bf16_t*)(FWS(F) + WS_WIN) + (size_t)l * DINP * D, scr, r, F.lane); continue; } r -= I_IN;
            p0_transpose_item(F.tab[I_WOUT] + (size_t)l * D * D, D, D, (bf16_t*)(FWS(F) + WS_WOUT) + (size_t)l * D * D, scr, r, F.lane);
        }
        {
            const int fr = F.lane & 15, fg = F.lane >> 4;
            for (int it = gw; it < 2 * 16 * 2 * 16; it += NGW) {
                const int kt4 = it & 15, nh = (it >> 4) & 1, hp = (it >> 5) & 15, l = it >> 9;
                bf16x8 bfr[4][4];
#pragma unroll
                for (int q = 0; q < 4; ++q) {
                    const float* Bp = F.tab[I_PQW] + ((size_t)l * D + 16 * (4 * kt4 + q) + fr) * 2048 + hp * 128 + 8 * fg;
#pragma unroll
                    for (int ks = 0; ks < 4; ++ks) { const f32x4 b0 = *(const f32x4*)(Bp + 32 * ks), b1 = *(const f32x4*)(Bp + 32 * ks + 4);
                        bfr[q][ks] = __builtin_bit_cast(bf16x8, (u32x4){pk2(b0[0], b0[1]), pk2(b0[2], b0[3]), pk2(b1[0], b1[1]), pk2(b1[2], b1[3])}); }
                }
#pragma nounroll
                for (int n4 = 0; n4 < 4; ++n4) {
                    const int nt = 4 * nh + n4;
                    const float* Ap = F.tab[I_PSK] + (((size_t)l * 16 + hp) * 128 + 16 * nt + fr) * 128 + 8 * fg;
                    bf16x8 af[4];
#pragma unroll
                    for (int ks = 0; ks < 4; ++ks) { const f32x4 a0 = *(const f32x4*)(Ap + 32 * ks), a1 = *(const f32x4*)(Ap + 32 * ks + 4);
                        af[ks] = __builtin_bit_cast(bf16x8, (u32x4){pk2(a0[0], a0[1]), pk2(a0[2], a0[3]), pk2(a1[0], a1[1]), pk2(a1[2], a1[3])}); }
#pragma unroll
                    for (int q = 0; q < 4; ++q) {
                        f32x4 acc = (f32x4){0.f, 0.f, 0.f, 0.f};
#pragma unroll
                        for (int ks = 0; ks < 4; ++ks) acc = __builtin_amdgcn_mfma_f32_16x16x32_bf16(af[ks], bfr[q][ks], acc, 0, 0, 0);
                        bf16_t* o = (bf16_t*)(FWS(F) + WS_QW) + ((size_t)l * 2048 + hp * 128 + 16 * nt + 4 * fg) * D + 16 * (4 * kt4 + q) + fr;
#pragma unroll
                        for (int rg = 0; rg < 4; ++rg) o[(size_t)rg * D] = (bf16_t)f2bf(acc[rg]);
                    }
                }
            }
        }
    }
    const size_t gt = (size_t)F.bid * NTHR + F.tid, GT = (size_t)F.G * NTHR;
    for (size_t i = gt; i < (size_t)2 * 128 * D / 8; i += GT) { const size_t l = i / (128 * D / 8), r = i % (128 * D / 8);
        *(u32x4*)((bf16_t*)(FWS(F) + WS_WIN) + (l * DINP + DIN) * D + r * 8) = (u32x4){0u, 0u, 0u, 0u}; }
    for (size_t i = gt; i < (size_t)2 * 2 * 256 * 64; i += GT) {
        const int r = (int)(i & 63), c = (int)((i >> 6) & 255); const size_t ld = i >> 14;
        ((bf16_t*)(FWS(F) + WS_WUPT))[i] = (bf16_t)f2bf(F.tab[I_RWUP][(ld * 64 + r) * 256 + c]);
        ((bf16_t*)(FWS(F) + WS_AUPT))[i] = (bf16_t)f2bf(F.tab[I_RAUP][(ld * 64 + r) * 256 + c]);
    }
    convert_peer_tables(F, 0, PN / 4, F.bid * NWAVES + F.wave, F.G * NWAVES);
    {
        __syncthreads();
        LAS float* sv = (LAS float*)F.lds;
        LAS float* red = (LAS float*)(F.lds + 17 * 1024 * 4);
        if (F.bid < 384) {
#pragma unroll
            for (int hb = 0; hb < 2; ++hb) { float xv[17];
#pragma unroll
                for (int it = 0; it < 17; ++it) { const int i = F.tid + NTHR * (17 * hb + it); xv[it] = (i < 16 * 1024) ? F.tab[I_C][i] : F.tab[I_CCTX][i - 16 * 1024]; }
#pragma unroll
                for (int it = 0; it < 17; ++it) { const int i = F.tid + NTHR * (17 * hb + it); sv[i] = xv[it] * sigmoidf_(xv[it]); } }
        }
        __syncthreads();
        for (int it = F.bid; it < 384; it += F.G) {
            const int l = it / 192, n0 = (it % 192) * 32;
            const int kg = F.tid >> 3, cq = F.tid & 7;
            float acc[17][4];
#pragma unroll
            for (int r = 0; r < 17; ++r) { acc[r][0] = 0.f; acc[r][1] = 0.f; acc[r][2] = 0.f; acc[r][3] = 0.f; }
            const float* W = F.tab[I_ADAW] + (size_t)l * D * 6144 + n0 + 4 * cq;
#pragma nounroll
            for (int hb = 0; hb < 2; ++hb) {
                f32x4 wv[8];
#pragma unroll
                for (int i = 0; i < 8; ++i) wv[i] = *(const f32x4*)(W + (size_t)(kg + 64 * (8 * hb + i)) * 6144);
#pragma unroll
                for (int i = 0; i < 8; ++i) { const f32x4 w = wv[i]; const int k = kg + 64 * (8 * hb + i);
#pragma unroll
                    for (int r = 0; r < 17; ++r) { const float s = sv[r * 1024 + k]; acc[r][0] += s * w[0]; acc[r][1] += s * w[1]; acc[r][2] += s * w[2]; acc[r][3] += s * w[3]; }
                }
            }
#pragma unroll
            for (int r = 0; r < 17; ++r)
#pragma unroll
                for (int j = 0; j < 4; ++j) { float v = acc[r][j]; v += __shfl_xor(v, 8); v += __shfl_xor(v, 16); v += __shfl_xor(v, 32); acc[r][j] = v; }
            if (F.lane < 8) {
#pragma unroll
                for (int r = 0; r < 17; ++r)
#pragma unroll
                    for (int j = 0; j < 4; ++j) red[(F.wave * 17 + r) * 32 + 4 * cq + j] = acc[r][j];
            }
            __syncthreads();
            for (int i = F.tid; i < 17 * 32; i += NTHR) { float s = 0.f;
#pragma unroll
                for (int w = 0; w < 8; ++w) s += red[w * 17 * 32 + i];
                const int r = i / 32, n = n0 + (i & 31);
                ((float*)(FWS(F) + WS_MOD))[((size_t)l * 17 + r) * 6144 + n] = s + F.tab[I_ADAB][(size_t)l * 6144 + n]; }
            __syncthreads();
        }
    }
}

__device__ __forceinline__ void norm_mod_finish(const f32x4 (&v)[4], float s, const float* g, const float* modrow_sh, bf16_t* orow, int lane) {
    const float rs = rsqrtf(wave_sum(s) * (1.f / D) + 1e-6f);
    u32x2* o8 = (u32x2*)orow + lane;
#pragma unroll
    for (int j = 0; j < 4; ++j) {
        const f32x4 gg = ((const f32x4*)g + lane)[64 * j], sh = ((const f32x4*)modrow_sh + lane)[64 * j], sc = ((const f32x4*)(modrow_sh + 1024) + lane)[64 * j];
        const f32x4 y = v[j] * rs * gg * (sc + 1.0f) + sh;
        u32x2 w; w.x = pk2(y[0], y[1]); w.y = pk2(y[2], y[3]); o8[64 * j] = w;
    }
}
__device__ __forceinline__ void norm_mod_phase(Frame& F, const float* xl, const float* xc, const float* g, const float* mod, int shoff, int nrows) {
    const int gw = F.bid * NWAVES + F.wave, NGW = F.G * NWAVES, lane = F.lane;
    bf16_t* H = (bf16_t*)(FWS(F) + WS_H);
    const int per = (nrows + NGW - 1) / NGW;
    int m = gw * per; const int mend = m + per < nrows ? m + per : nrows;
    if (m >= mend) return;
    f32x4 pA[4], pS[4]; int cur = -1;
    f32x4 v[2][4], vn[2][4];
#pragma unroll
    for (int q = 0; q < 2; ++q) { const int r = m + q < mend ? m + q : m; const float* xr = (r >= NLAT) ? xc + (size_t)(r - NLAT) * D : xl + (size_t)r * D;
#pragma unroll
        for (int j = 0; j < 4; ++j) v[q][j] = ((const f32x4*)xr + lane)[64 * j]; }
    for (; m < mend; m += 2) {
#pragma unroll
        for (int q = 0; q < 2; ++q) { const int r = m + 2 + q < mend ? m + 2 + q : m; const float* xr = (r >= NLAT) ? xc + (size_t)(r - NLAT) * D : xl + (size_t)r * D;
#pragma unroll
            for (int j = 0; j < 4; ++j) vn[q][j] = ((const f32x4*)xr + lane)[64 * j]; }
#pragma unroll
        for (int q = 0; q < 2; ++q) {
            const int r = m + q; if (r >= mend) break;
            const int mrow = (r >= NLAT) ? 16 : r / SEQ;
            if (mrow != cur) { cur = mrow; const float* shp = mod + (size_t)mrow * 6144 + shoff;
#pragma unroll
                for (int j = 0; j < 4; ++j) { pA[j] = ((const f32x4*)g + lane)[64 * j] * (((const f32x4*)(shp + 1024) + lane)[64 * j] + 1.0f); pS[j] = ((const f32x4*)shp + lane)[64 * j]; } }
            float s = 0.f;
#pragma unroll
            for (int j = 0; j < 4; ++j) s += (v[q][j].x * v[q][j].x + v[q][j].y * v[q][j].y) + (v[q][j].z * v[q][j].z + v[q][j].w * v[q][j].w);
            const float rs = rsqrtf(wave_sum(s) * (1.f / D) + 1e-6f);
            u32x2* o8 = (u32x2*)(H + (size_t)r * D) + lane;
#pragma unroll
            for (int j = 0; j < 4; ++j) { const f32x4 y = v[q][j] * rs * pA[j] + pS[j]; u32x2 w; w.x = pk2(y[0], y[1]); w.y = pk2(y[2], y[3]); o8[64 * j] = w; }
        }
#pragma unroll
        for (int q = 0; q < 2; ++q)
#pragma unroll
            for (int j = 0; j < 4; ++j) v[q][j] = vn[q][j];
    }
}

__device__ __forceinline__ void norm_mod_phase_xr(Frame& F, const float* g, const float* mod, int shoff, int nrows) {
    const int gw = F.bid * NWAVES + F.wave, NGW = F.G * NWAVES, lane = F.lane;
    const bf16_t* XR = (const bf16_t*)(FWS(F) + WS_XR); bf16_t* H = (bf16_t*)(FWS(F) + WS_H);
    const int per = (nrows + NGW - 1) / NGW;
    int m = gw * per; const int mend = m + per < nrows ? m + per : nrows;
    if (m >= mend) return;
    f32x4 pA[4], pS[4]; int cur = -1;
    u32x4 w[2][2], wn[2][2];
#pragma unroll
    for (int q = 0; q < 2; ++q) { const int r = m + q < mend ? m + q : m; w[q][0] = *(const u32x4*)(XR + (size_t)r * D + 16 * lane); w[q][1] = *(const u32x4*)(XR + (size_t)r * D + 16 * lane + 8); }
    for (; m < mend; m += 2) {
#pragma unroll
        for (int q = 0; q < 2; ++q) { const int r = m + 2 + q < mend ? m + 2 + q : m; wn[q][0] = *(const u32x4*)(XR + (size_t)r * D + 16 * lane); wn[q][1] = *(const u32x4*)(XR + (size_t)r * D + 16 * lane + 8); }
#pragma unroll
        for (int q = 0; q < 2; ++q) {
            const int r = m + q; if (r >= mend) break;
            const int mrow = (r >= NLAT) ? 16 : r / SEQ;
            if (mrow != cur) { cur = mrow; const float* shp = mod + (size_t)mrow * 6144 + shoff + 16 * lane;
#pragma unroll
                for (int j4 = 0; j4 < 4; ++j4) { pA[j4] = *(const f32x4*)(g + 16 * lane + 4 * j4) * (*(const f32x4*)(shp + 1024 + 4 * j4) + 1.0f); pS[j4] = *(const f32x4*)(shp + 4 * j4); } }
            float x[16]; { float t[8]; unpack8(w[q][0], t);
#pragma unroll
                for (int j = 0; j < 8; ++j) x[j] = t[j];
                unpack8(w[q][1], t);
#pragma unroll
                for (int j = 0; j < 8; ++j) x[8 + j] = t[j]; }
            float s = 0.f;
#pragma unroll
            for (int j = 0; j < 16; ++j) s += x[j] * x[j];
            const float rs = rsqrtf(wave_sum(s) * (1.f / D) + 1e-6f);
            unsigned o[8];
#pragma unroll
            for (int j4 = 0; j4 < 4; ++j4) { const f32x4 y = (f32x4){x[4 * j4], x[4 * j4 + 1], x[4 * j4 + 2], x[4 * j4 + 3]} * rs * pA[j4] + pS[j4];
                o[2 * j4] = pk2(y[0], y[1]); o[2 * j4 + 1] = pk2(y[2], y[3]); }
            *(u32x4*)(H + (size_t)r * D + 16 * lane) = (u32x4){o[0], o[1], o[2], o[3]}; *(u32x4*)(H + (size_t)r * D + 16 * lane + 8) = (u32x4){o[4], o[5], o[6], o[7]};
        }
#pragma unroll
        for (int q = 0; q < 2; ++q) { w[q][0] = wn[q][0]; w[q][1] = wn[q][1]; }
    }
}

constexpr int SCH = 32;
__device__ __forceinline__ int scan_row(int b, int dir, int s) {
    return dir == 0 ? (s < CTXL ? NLAT + b * CTXL + s : b * SEQ + (s - CTXL)) : (s < CTXL ? NLAT + b * CTXL + (CTXL - 1 - s) : b * SEQ + (SEQ - 1 - (s - CTXL)));
}
__device__ __forceinline__ int scan_row_u(int b, int dir, int cbase, int off) {
    const bool isctx = cbase < CTXL;
    const int base = dir == 0 ? (isctx ? NLAT + b * CTXL : b * SEQ - CTXL) + cbase : (isctx ? NLAT + b * CTXL + CTXL - 1 : b * SEQ + SEQ - 1 + CTXL) - cbase;
    return dir == 0 ? base + off : base - off;
}
struct ScanOps { f32x4 kk[2], w[2], b[2], kd[2], r[2]; float v; };
__device__ __forceinline__ float fsigmoid(float x) { return __builtin_amdgcn_rcpf(1.0f + __builtin_amdgcn_exp2f(-1.4426950408889634f * x)); }
__device__ __forceinline__ float ftanh(float x) { const float e = __builtin_amdgcn_exp2f(-2.8853900817779268f * fabsf(x)); const float t = (1.0f - e) * __builtin_amdgcn_rcpf(1.0f + e); return x < 0.f ? -t : t; }
__device__ __forceinline__ void scan_unit(Frame& F, int layer, int b, int h, int dir, int half) {
    const bf16_t* Z = (const bf16_t*)(FWS(F) + WS_Z);
    float* YS = (float*)(FWS(F) + WS_Z) + (size_t)dir * NTOK * RWW;
    LAS float* L0 = (LAS float*)F.lds;
    constexpr int BUFW = 7 * 2048;
    LAS float* YB0 = L0 + 2 * BUFW;
    const int tid = F.tid, lane = F.lane, wave = F.wave, fr = lane & 15, fg = lane >> 4;
    constexpr int NCH = (CTXL + SEQ) / SCH;
    if (wave < 4) {
        const int srow = tid >> 3, jq = tid & 7, si = 32 * half + srow;
        f32x4 S0 = (f32x4){0.f, 0.f, 0.f, 0.f}, S1 = (f32x4){0.f, 0.f, 0.f, 0.f};
        __syncthreads();
        for (int c = 0; c < NCH; ++c) {
            LAS float* Rl = L0 + (c & 1) * BUFW; LAS float* KKl = Rl + 2048; LAS float* Vl = Rl + 4096; LAS float* Wl = Rl + 6144; LAS float* Bl = Rl + 8192; LAS float* KDl = Rl + 10240;
            LAS float* YBl = YB0 + (c & 1) * 1024;
#define SCAN_LOAD(o, t) do { _Pragma("unroll") for (int _h = 0; _h < 2; ++_h) { \
        (o).kk[_h] = *(const LAS f32x4*)(KKl + (t) * 64 + 8 * jq + 4 * _h); (o).w[_h] = *(const LAS f32x4*)(Wl + (t) * 64 + 8 * jq + 4 * _h); (o).b[_h] = *(const LAS f32x4*)(Bl + (t) * 64 + 8 * jq + 4 * _h); \
        (o).kd[_h] = *(const LAS f32x4*)(KDl + (t) * 64 + 8 * jq + 4 * _h); (o).r[_h] = *(const LAS f32x4*)(Rl + (t) * 64 + 8 * jq + 4 * _h); } (o).v = Vl[(t) * 64 + si]; } while (0)
#define SCAN_STEP(o, t) do { \
        const f32x4 _pa = S0 * (o).kk[0] + S1 * (o).kk[1]; float sa = (_pa[0] + _pa[1]) + (_pa[2] + _pa[3]); sa = sum8(sa); \
        S0 = S0 * (o).w[0] + ((o).kd[0] * (o).v - (o).b[0] * sa); S1 = S1 * (o).w[1] + ((o).kd[1] * (o).v - (o).b[1] * sa); \
        const f32x4 _py = S0 * (o).r[0] + S1 * (o).r[1]; float y = (_py[0] + _py[1]) + (_py[2] + _py[3]); y = sum8(y); \
        if (jq == 0) YBl[(t) * 32 + srow] = y; } while (0)
            ScanOps oa, ob;
            SCAN_LOAD(oa, 0);
#pragma unroll 1
            for (int t = 0; t < SCH; t += 2) {
                SCAN_LOAD(ob, t + 1);
                SCAN_STEP(oa, t);
                if (t + 2 < SCH) SCAN_LOAD(oa, t + 2);
                SCAN_STEP(ob, t + 1);
            }
#undef SCAN_LOAD
#undef SCAN_STEP
            __syncthreads();
        }
    } else if (wave < 6) {
        const int pw = wave - 4;
        const bf16_t* WUP = (const bf16_t*)(FWS(F) + WS_WUPT) + ((size_t)(layer * 2 + dir) * 256 + 64 * h + fr) * 64 + 8 * fg;
        const bf16_t* AUP = (const bf16_t*)(FWS(F) + WS_AUPT) + ((size_t)(layer * 2 + dir) * 256 + 64 * h + fr) * 64 + 8 * fg;
        const float* W0P = F.tab[I_RW0] + (size_t)(layer * 2 + dir) * 256 + 64 * h + fr; const float* A0P = F.tab[I_RA0] + (size_t)(layer * 2 + dir) * 256 + 64 * h + fr;
        const int tl = lane >> 2, q16 = (lane & 3) * 16;
        const float* KKP = F.tab[I_RKK] + (size_t)layer * 256 + 64 * h + q16; const float* KAP = F.tab[I_RKA] + (size_t)layer * 256 + 64 * h + q16;
        u32x4 pw_[2], pa_[2], prr[2], pkk[2], pvv[2];
#define P_LOAD(cc) do { \
        { const size_t zr = (size_t)scan_row(b, dir, (cc) * SCH + 16 * pw + fr) * DINP + 64 * dir + 8 * fg; \
          pw_[0] = *(const u32x4*)(Z + zr + ZW); pw_[1] = *(const u32x4*)(Z + zr + ZW + 32); pa_[0] = *(const u32x4*)(Z + zr + ZA); pa_[1] = *(const u32x4*)(Z + zr + ZA + 32); } \
        { const size_t zr = (size_t)scan_row(b, dir, (cc) * SCH + 16 * pw + tl) * DINP + 64 * h + q16; \
          prr[0] = *(const u32x4*)(Z + zr + ZR); prr[1] = *(const u32x4*)(Z + zr + ZR + 8); pkk[0] = *(const u32x4*)(Z + zr + ZK); pkk[1] = *(const u32x4*)(Z + zr + ZK + 8); \
          pvv[0] = *(const u32x4*)(Z + zr + ZV); pvv[1] = *(const u32x4*)(Z + zr + ZV + 8); } } while (0)
#define P_COMPUTE(cc) do { \
        LAS float* Rl = L0 + ((cc) & 1) * BUFW; LAS float* KKl = Rl + 2048; LAS float* Vl = Rl + 4096; LAS float* Wl = Rl + 6144; LAS float* Bl = Rl + 8192; LAS float* KDl = Rl + 10240; LAS float* ATl = Rl + 12288; \
        { bf16x8 aw[2]; \
          _Pragma("unroll") for (int ks = 0; ks < 2; ++ks) { float f[8]; u32x4 o; unpack8(pw_[ks], f); \
              o.x = pk2(ftanh(f[0]), ftanh(f[1])); o.y = pk2(ftanh(f[2]), ftanh(f[3])); o.z = pk2(ftanh(f[4]), ftanh(f[5])); o.w = pk2(ftanh(f[6]), ftanh(f[7])); aw[ks] = __builtin_bit_cast(bf16x8, o); } \
          _Pragma("unroll") for (int ct = 0; ct < 4; ++ct) { \
              f32x4 accw = (f32x4){0.f, 0.f, 0.f, 0.f}, acca = (f32x4){0.f, 0.f, 0.f, 0.f}; const float w0c = W0P[16 * ct], a0c = A0P[16 * ct]; \
              accw = __builtin_amdgcn_mfma_f32_16x16x32_bf16(aw[0], *(const bf16x8*)(WUP + ct * 1024), accw, 0, 0, 0); accw = __builtin_amdgcn_mfma_f32_16x16x32_bf16(aw[1], *(const bf16x8*)(WUP + ct * 1024 + 32), accw, 0, 0, 0); \
              acca = __builtin_amdgcn_mfma_f32_16x16x32_bf16(__builtin_bit_cast(bf16x8, pa_[0]), *(const bf16x8*)(AUP + ct * 1024), acca, 0, 0, 0); acca = __builtin_amdgcn_mfma_f32_16x16x32_bf16(__builtin_bit_cast(bf16x8, pa_[1]), *(const bf16x8*)(AUP + ct * 1024 + 32), acca, 0, 0, 0); \
              _Pragma("unroll") for (int rg = 0; rg < 4; ++rg) { const int o_ = (16 * pw + 4 * fg + rg) * 64 + 16 * ct + fr; \
                  Wl[o_] = __builtin_amdgcn_exp2f(-0.8750387749589899f * fsigmoid(accw[rg] + w0c)); ATl[o_] = fsigmoid(acca[rg] + a0c); } } } \
        asm volatile("s_waitcnt lgkmcnt(0)" ::: "memory"); \
        { float rr[16], kk_[16], vv_[16]; \
          { float t_[8]; unpack8(prr[0], t_); _Pragma("unroll") for (int j = 0; j < 8; ++j) rr[j] = t_[j]; unpack8(prr[1], t_); _Pragma("unroll") for (int j = 0; j < 8; ++j) rr[8 + j] = t_[j]; \
            unpack8(pkk[0], t_); _Pragma("unroll") for (int j = 0; j < 8; ++j) kk_[j] = t_[j]; unpack8(pkk[1], t_); _Pragma("unroll") for (int j = 0; j < 8; ++j) kk_[8 + j] = t_[j]; \
            unpack8(pvv[0], t_); _Pragma("unroll") for (int j = 0; j < 8; ++j) vv_[j] = t_[j]; unpack8(pvv[1], t_); _Pragma("unroll") for (int j = 0; j < 8; ++j) vv_[8 + j] = t_[j]; } \
          float ss = 0.f; float qn[16]; \
          _Pragma("unroll") for (int j = 0; j < 16; ++j) { qn[j] = kk_[j] * KKP[j]; ss += qn[j] * qn[j]; } \
          ss += dppf<XOR1>(ss); ss += dppf<XOR2>(ss); \
          const float inv = rsqrtf(ss + 1e-12f); \
          const int o_ = (16 * pw + tl) * 64 + q16; \
          _Pragma("unroll") for (int j4 = 0; j4 < 4; ++j4) { \
              const f32x4 a_ = *(const LAS f32x4*)(ATl + o_ + 4 * j4); const f32x4 ka_ = *(const f32x4*)(KAP + 4 * j4); \
              const f32x4 kq = (f32x4){qn[4 * j4] * inv, qn[4 * j4 + 1] * inv, qn[4 * j4 + 2] * inv, qn[4 * j4 + 3] * inv}; \
              *(LAS f32x4*)(Rl + o_ + 4 * j4) = (f32x4){rr[4 * j4], rr[4 * j4 + 1], rr[4 * j4 + 2], rr[4 * j4 + 3]}; \
              *(LAS f32x4*)(KKl + o_ + 4 * j4) = kq; \
              *(LAS f32x4*)(Vl + o_ + 4 * j4) = (f32x4){vv_[4 * j4], vv_[4 * j4 + 1], vv_[4 * j4 + 2], vv_[4 * j4 + 3]}; \
              *(LAS f32x4*)(Bl + o_ + 4 * j4) = kq * a_; \
              *(LAS f32x4*)(KDl + o_ + 4 * j4) = (f32x4){kk_[4 * j4] * (1.f + (a_[0] - 1.f) * ka_[0]), kk_[4 * j4 + 1] * (1.f + (a_[1] - 1.f) * ka_[1]), kk_[4 * j4 + 2] * (1.f + (a_[2] - 1.f) * ka_[2]), kk_[4 * j4 + 3] * (1.f + (a_[3] - 1.f) * ka_[3])}; } } \
        } while (0)
        P_LOAD(0);
        P_COMPUTE(0);
        P_LOAD(1);
        __syncthreads();
        for (int c = 0; c < NCH; ++c) {
            if (c + 1 < NCH) { P_COMPUTE(c + 1); if (c + 2 < NCH) P_LOAD(c + 2); }
            __syncthreads();
        }
#undef P_LOAD
#undef P_COMPUTE
    } else {
        const int ft = tid - 384;
        __syncthreads();
        for (int c = 0; c < NCH; ++c) {
            if (c > 0) { const LAS float* YBl = YB0 + ((c - 1) & 1) * 1024;
#pragma unroll
                for (int i = 0; i < 2; ++i) { const int idx = ft + 128 * i, tf = idx >> 3, r4 = (idx & 7) * 4; const size_t row = (size_t)scan_row(b, dir, (c - 1) * SCH + tf);
                    *(f32x4*)(YS + row * RWW + 64 * h + 32 * half + r4) = *(const LAS f32x4*)(YBl + tf * 32 + r4); } }
            __syncthreads();
        }
        { const LAS float* YBl = YB0 + ((NCH - 1) & 1) * 1024;
#pragma unroll
            for (int i = 0; i < 2; ++i) { const int idx = ft + 128 * i, tf = idx >> 3, r4 = (idx & 7) * 4; const size_t row = (size_t)scan_row(b, dir, (NCH - 1) * SCH + tf);
                *(f32x4*)(YS + row * RWW + 64 * h + 32 * half + r4) = *(const LAS f32x4*)(YBl + tf * 32 + r4); } }
    }
    __syncthreads();
}

constexpr int CK = 16, NCK = (CTXL + SEQ) / CK;
constexpr int CS_KT = 0, CS_RT = 2048, CS_BH = 4096, CS_VT = 8192, CS_NKT = 10240, CS_TT = 10752, CS_MT = 11264, CS_GC = 12288, CS_SET = 12544;
constexpr int CS_WL = 6 * CS_SET;
constexpr int CS_PRIV = 8 * CS_SET;
constexpr int CS_PRIV_SZ = 11264;
constexpr int CS_PAR = CS_PRIV + 4 * CS_PRIV_SZ;
static_assert(CS_PAR + 1024 <= LDS_BYTES - 64, "chunked scan LDS");
__device__ __forceinline__ bf16x8 mk8(u32x2 lo, u32x2 hi) { return __builtin_bit_cast(bf16x8, (u32x4){lo.x, lo.y, hi.x, hi.y}); }
__device__ __forceinline__ u32x2 tr4(const LAS bf16_t* img, int j0, int fr) { typedef short s16x4 __attribute__((ext_vector_type(4)));
    return __builtin_bit_cast(u32x2, __builtin_amdgcn_ds_read_tr16_b64_v4i16((LAS s16x4*)(img + (j0 + (fr >> 2)) * 16 + 4 * (fr & 3)))); }
__device__ __forceinline__ void scan_chunked(Frame& F, int layer, int b, int h, int dir) {
    const bf16_t* Z = (const bf16_t*)(FWS(F) + WS_Z);
    bf16_t* YS = (bf16_t*)(FWS(F) + WS_YS) + (size_t)dir * NTOK * RWW;
    const int lane = F.lane, wave = F.wave, fr = lane & 15, fg = lane >> 4;
#define CS_SLOT(c) ((((c) & 2) ? 2 + (((c) >> 1) & 2) : 0) + ((c) & 1))
#define CK_BAR() do { asm volatile("s_waitcnt lgkmcnt(0)" ::: "memory"); __builtin_amdgcn_s_barrier(); asm volatile("" ::: "memory"); } while (0)
    constexpr int NBAR = NCK + 4;
    { LAS float* PAR = (LAS float*)(F.lds + CS_PAR); const int t_ = F.tid;
      if (t_ < 256) { const int which = t_ >> 6, cch = t_ & 63;
          const float* src = which == 0 ? F.tab[I_RW0] + (size_t)(layer * 2 + dir) * 256 : which == 1 ? F.tab[I_RA0] + (size_t)(layer * 2 + dir) * 256 : which == 2 ? F.tab[I_RKK] + (size_t)layer * 256 : F.tab[I_RKA] + (size_t)layer * 256;
          PAR[t_] = src[64 * h + cch]; }
#pragma unroll
      for (int rep = 0; rep < 2; ++rep) { const int idx = t_ + NTHR * rep, l_ = idx & 63, fid = idx >> 6, k2 = fid & 1, ct_ = (fid >> 1) & 3, m_ = fid >> 3;
          const bf16_t* srcw = (const bf16_t*)(FWS(F) + (m_ ? WS_AUPT : WS_WUPT)) + ((size_t)(layer * 2 + dir) * 256 + 64 * h + 16 * ct_ + (l_ & 15)) * 64 + 32 * k2 + 8 * (l_ >> 4);
          *(LAS u32x4*)(F.lds + CS_WL + idx * 16) = *(const u32x4*)srcw; }
      __syncthreads(); }
    if (wave < 4) {
        const int i = 16 * wave + fr;
        f32x4 ST[4];
#pragma unroll
        for (int jt = 0; jt < 4; ++jt) ST[jt] = (f32x4){0.f, 0.f, 0.f, 0.f};
        CK_BAR(); CK_BAR(); CK_BAR(); CK_BAR();
        for (int c = 0; c < NCK; ++c) {
            const LAS unsigned char* bs = F.lds + (CS_SLOT(c) * CS_SET);
            const LAS bf16_t* KT = (const LAS bf16_t*)(bs + CS_KT); const LAS bf16_t* RT = (const LAS bf16_t*)(bs + CS_RT); const LAS bf16_t* BH = (const LAS bf16_t*)(bs + CS_BH);
            const LAS bf16_t* VT = (const LAS bf16_t*)(bs + CS_VT); const LAS bf16_t* NKT = (const LAS bf16_t*)(bs + CS_NKT); const LAS bf16_t* TT = (const LAS bf16_t*)(bs + CS_TT);
            const LAS bf16_t* MT = (const LAS bf16_t*)(bs + CS_MT); const LAS float* GC = (const LAS float*)(bs + CS_GC);
            bf16x8 Sb[2];
#pragma unroll
            for (int ks = 0; ks < 2; ++ks) { u32x4 o; o.x = pk2(ST[2 * ks][0], ST[2 * ks][1]); o.y = pk2(ST[2 * ks][2], ST[2 * ks][3]); o.z = pk2(ST[2 * ks + 1][0], ST[2 * ks + 1][1]); o.w = pk2(ST[2 * ks + 1][2], ST[2 * ks + 1][3]); Sb[ks] = __builtin_bit_cast(bf16x8, o); }
            const u32x4 z4 = (u32x4){0u, 0u, 0u, 0u};
            f32x4 WT = (f32x4){0.f, 0.f, 0.f, 0.f};
#pragma unroll
            for (int ks = 0; ks < 2; ++ks) WT = __builtin_amdgcn_mfma_f32_16x16x32_bf16(mk8(tr4(KT, 32 * ks + 4 * fg, fr), tr4(KT, 32 * ks + 16 + 4 * fg, fr)), Sb[ks], WT, 0, 0, 0);
            { const u32x4 an = *(const LAS u32x4*)(NKT + fr * 16 + 8 * (fg & 1)), bv = *(const LAS u32x4*)(VT + i * 16 + 8 * (fg & 1));
              WT = __builtin_amdgcn_mfma_f32_16x16x32_bf16(__builtin_bit_cast(bf16x8, fg < 2 ? an : z4), __builtin_bit_cast(bf16x8, fg < 2 ? bv : z4), WT, 0, 0, 0); }
            f32x4 UT;
            { const u32x2 at = tr4(TT, 4 * fg, fr); u32x4 bw; bw.x = pk2(WT[0], WT[1]); bw.y = pk2(WT[2], WT[3]); bw.z = 0u; bw.w = 0u;
              UT = __builtin_amdgcn_mfma_f32_16x16x32_bf16(__builtin_bit_cast(bf16x8, (u32x4){at.x, at.y, 0u, 0u}), __builtin_bit_cast(bf16x8, bw), (f32x4){0.f, 0.f, 0.f, 0.f}, 0, 0, 0); }
            bf16x8 Buv;
            { const u32x2 vv = *(const LAS u32x2*)(VT + i * 16 + 4 * fg); u32x4 o; o.x = pk2(UT[0], UT[1]); o.y = pk2(UT[2], UT[3]); o.z = vv.x; o.w = vv.y; Buv = __builtin_bit_cast(bf16x8, o); }
            f32x4 YT = (f32x4){0.f, 0.f, 0.f, 0.f};
#pragma unroll
            for (int ks = 0; ks < 2; ++ks) YT = __builtin_amdgcn_mfma_f32_16x16x32_bf16(mk8(tr4(RT, 32 * ks + 4 * fg, fr), tr4(RT, 32 * ks + 16 + 4 * fg, fr)), Sb[ks], YT, 0, 0, 0);
            YT = __builtin_amdgcn_mfma_f32_16x16x32_bf16(*(const LAS bf16x8*)(MT + fr * 32 + 8 * fg), Buv, YT, 0, 0, 0);
#pragma unroll
            for (int rg = 0; rg < 4; ++rg) { const size_t row = (size_t)scan_row_u(b, dir, c * CK, 4 * fg + rg); YS[row * RWW + 64 * h + i] = (bf16_t)f2bf(YT[rg]); }
#pragma unroll
            for (int jt = 0; jt < 4; ++jt) { const f32x4 gc = *(const LAS f32x4*)(GC + 16 * jt + 4 * fg);
                ST[jt] = __builtin_amdgcn_mfma_f32_16x16x32_bf16(*(const LAS bf16x8*)(BH + (16 * jt + fr) * 32 + 8 * fg), Buv, ST[jt] * gc, 0, 0, 0); }
            CK_BAR();
        }
    } else {
        const int p = wave - 4;
        LAS unsigned char* priv = F.lds + CS_PRIV + p * CS_PRIV_SZ;
        LAS bf16_t* BT = (LAS bf16_t*)priv; LAS bf16_t* KDT = (LAS bf16_t*)(priv + 2048); LAS float* NB = (LAS float*)(priv + 4096);
        const bf16_t* WUP = (const bf16_t*)(FWS(F) + WS_WUPT) + ((size_t)(layer * 2 + dir) * 256 + 64 * h + fr) * 64 + 8 * fg;
        const bf16_t* AUP = (const bf16_t*)(FWS(F) + WS_AUPT) + ((size_t)(layer * 2 + dir) * 256 + 64 * h + fr) * 64 + 8 * fg;
        const LAS float* W0Q = (const LAS float*)(F.lds + CS_PAR) + fr; const LAS float* A0Q = W0Q + 64; const LAS float* KKQ = W0Q + 128; const LAS float* KAQ = W0Q + 192;
        LAS bf16_t* RAW = (LAS bf16_t*)(priv + 5120);
        const int tl = lane >> 2, q16 = (lane & 3) * 16;
        u32x4 pw0, pw1, pa0, pa1, pr0, pr1, pk0, pk1, pv0, pv1;
#define CK_LOAD(cc) do { \
        { const size_t zr = (size_t)scan_row_u(b, dir, (cc) * CK, fr) * DINP + 64 * dir + 8 * fg; \
          pw0 = *(const u32x4*)(Z + zr + ZW); pw1 = *(const u32x4*)(Z + zr + ZW + 32); pa0 = *(const u32x4*)(Z + zr + ZA); pa1 = *(const u32x4*)(Z + zr + ZA + 32); } \
        { const size_t zr = (size_t)scan_row_u(b, dir, (cc) * CK, tl) * DINP + 64 * h + q16; \
          pr0 = *(const u32x4*)(Z + zr + ZR); pr1 = *(const u32x4*)(Z + zr + ZR + 8); pk0 = *(const u32x4*)(Z + zr + ZK); pk1 = *(const u32x4*)(Z + zr + ZK + 8); \
          pv0 = *(const u32x4*)(Z + zr + ZV); pv1 = *(const u32x4*)(Z + zr + ZV + 8); } } while (0)
        CK_LOAD(p);
        float w0r[4], a0r[4], kkr[4], kar[4];
#pragma unroll
        for (int ct = 0; ct < 4; ++ct) { w0r[ct] = W0Q[16 * ct]; a0r[ct] = A0Q[16 * ct]; kkr[ct] = KKQ[16 * ct]; kar[ct] = KAQ[16 * ct]; }
        int nbar = 0;
        for (int c = p; c < NCK; c += 4) {
            LAS unsigned char* bs = F.lds + (CS_SLOT(c) * CS_SET);
            LAS bf16_t* KT = (LAS bf16_t*)(bs + CS_KT); LAS bf16_t* RT = (LAS bf16_t*)(bs + CS_RT); LAS bf16_t* BH = (LAS bf16_t*)(bs + CS_BH);
            LAS bf16_t* VT = (LAS bf16_t*)(bs + CS_VT); LAS bf16_t* NKT = (LAS bf16_t*)(bs + CS_NKT); LAS bf16_t* TT = (LAS bf16_t*)(bs + CS_TT);
            LAS bf16_t* MT = (LAS bf16_t*)(bs + CS_MT); LAS float* GC = (LAS float*)(bs + CS_GC);
            f32x4 dl[4], av[4];
            {
                bf16x8 bwf[4][2], baf[4][2];
#pragma unroll
                for (int ct = 0; ct < 4; ++ct) { const LAS unsigned char* wl_ = F.lds + CS_WL + (ct * 128 + lane) * 16;
                    bwf[ct][0] = *(const LAS bf16x8*)wl_; bwf[ct][1] = *(const LAS bf16x8*)(wl_ + 1024); baf[ct][0] = *(const LAS bf16x8*)(wl_ + 8192); baf[ct][1] = *(const LAS bf16x8*)(wl_ + 8192 + 1024); }
                bf16x8 aw[2];
                { float f[8]; u32x4 o; unpack8(pw0, f); o.x = pk2(ftanh(f[0]), ftanh(f[1])); o.y = pk2(ftanh(f[2]), ftanh(f[3])); o.z = pk2(ftanh(f[4]), ftanh(f[5])); o.w = pk2(ftanh(f[6]), ftanh(f[7])); aw[0] = __builtin_bit_cast(bf16x8, o);
                  unpack8(pw1, f); o.x = pk2(ftanh(f[0]), ftanh(f[1])); o.y = pk2(ftanh(f[2]), ftanh(f[3])); o.z = pk2(ftanh(f[4]), ftanh(f[5])); o.w = pk2(ftanh(f[6]), ftanh(f[7])); aw[1] = __builtin_bit_cast(bf16x8, o); }
#pragma unroll
                for (int ct = 0; ct < 4; ++ct) {
                    f32x4 accw = (f32x4){0.f, 0.f, 0.f, 0.f}, acca = (f32x4){0.f, 0.f, 0.f, 0.f}; const float w0c = w0r[ct], a0c = a0r[ct];
                    accw = __builtin_amdgcn_mfma_f32_16x16x32_bf16(aw[0], bwf[ct][0], accw, 0, 0, 0); accw = __builtin_amdgcn_mfma_f32_16x16x32_bf16(aw[1], bwf[ct][1], accw, 0, 0, 0);
                    acca = __builtin_amdgcn_mfma_f32_16x16x32_bf16(__builtin_bit_cast(bf16x8, pa0), baf[ct][0], acca, 0, 0, 0); acca = __builtin_amdgcn_mfma_f32_16x16x32_bf16(__builtin_bit_cast(bf16x8, pa1), baf[ct][1], acca, 0, 0, 0);
#pragma unroll
                    for (int rg = 0; rg < 4; ++rg) { dl[ct][rg] = -0.8750387749589899f * fsigmoid(accw[rg] + w0c); av[ct][rg] = acca[rg] + a0c; }
                }
            }
            { LAS bf16_t* d = RAW + tl * 64 + q16; *(LAS u32x4*)d = pr0; *(LAS u32x4*)(d + 8) = pr1; *(LAS u32x4*)(d + 1024) = pk0; *(LAS u32x4*)(d + 1024 + 8) = pk1; *(LAS u32x4*)(d + 2048) = pv0; *(LAS u32x4*)(d + 2048 + 8) = pv1; }
            if (c + 4 < NCK) CK_LOAD(c + 4);
            asm volatile("s_waitcnt lgkmcnt(0)" ::: "memory");
            CK_BAR(); ++nbar;
#pragma unroll
            for (int ct = 0; ct < 4; ++ct)
#pragma unroll
                for (int rg = 0; rg < 4; ++rg) av[ct][rg] = fsigmoid(av[ct][rg]);
            float inv[4];
            {
                typedef short s16x4 __attribute__((ext_vector_type(4)));
                float ssq[4] = {0.f, 0.f, 0.f, 0.f};
#pragma unroll
                for (int ct = 0; ct < 4; ++ct) { const u32x2 kv = __builtin_bit_cast(u32x2, __builtin_amdgcn_ds_read_tr16_b64_v4i16((LAS s16x4*)(RAW + 1024 + (4 * fg + (fr >> 2)) * 64 + 16 * ct + 4 * (fr & 3))));
                    const float kq = kkr[ct]; const float q0 = bflo(kv.x) * kq, q1 = bfhi(kv.x) * kq, q2 = bflo(kv.y) * kq, q3 = bfhi(kv.y) * kq;
                    ssq[0] += q0 * q0; ssq[1] += q1 * q1; ssq[2] += q2 * q2; ssq[3] += q3 * q3; }
#pragma unroll
                for (int rg = 0; rg < 4; ++rg) inv[rg] = rsqrtf(sum16(ssq[rg]) + 1e-12f);
            }
            f32x4 lg[4]; float lgC[4];
#pragma unroll
            for (int ct = 0; ct < 4; ++ct) {
                lg[ct][0] = dl[ct][0]; lg[ct][1] = lg[ct][0] + dl[ct][1]; lg[ct][2] = lg[ct][1] + dl[ct][2]; lg[ct][3] = lg[ct][2] + dl[ct][3];
                const float tot = lg[ct][3];
                const float t1 = __shfl(tot, (lane + 48) & 63), t2 = __shfl(tot, (lane + 32) & 63), t3 = __shfl(tot, (lane + 16) & 63);
                const float off = (fg >= 1 ? t1 : 0.f) + (fg >= 2 ? t2 : 0.f) + (fg >= 3 ? t3 : 0.f);
                lg[ct] = lg[ct] + off;
                lgC[ct] = __shfl(lg[ct][3], 48 + fr);
            }
            CK_BAR(); ++nbar;
            float rx[4][4], kx[4][4]; u32x2 vraw[4];
#pragma unroll
            for (int ct = 0; ct < 4; ++ct) { typedef short s16x4 __attribute__((ext_vector_type(4)));
                const LAS bf16_t* zp = RAW + (4 * fg + (fr >> 2)) * 64 + 16 * ct + 4 * (fr & 3);
                const u32x2 rr = __builtin_bit_cast(u32x2, __builtin_amdgcn_ds_read_tr16_b64_v4i16((LAS s16x4*)zp)), kk = __builtin_bit_cast(u32x2, __builtin_amdgcn_ds_read_tr16_b64_v4i16((LAS s16x4*)(zp + 1024))),
                            vv = __builtin_bit_cast(u32x2, __builtin_amdgcn_ds_read_tr16_b64_v4i16((LAS s16x4*)(zp + 2048)));
                rx[ct][0] = bflo(rr.x); rx[ct][1] = bfhi(rr.x); rx[ct][2] = bflo(rr.y); rx[ct][3] = bfhi(rr.y);
                kx[ct][0] = bflo(kk.x); kx[ct][1] = bfhi(kk.x); kx[ct][2] = bflo(kk.y); kx[ct][3] = bfhi(kk.y);
                vraw[ct] = vv; }
            asm volatile("s_waitcnt lgkmcnt(0)" ::: "memory");
#pragma unroll
            for (int ct = 0; ct < 4; ++ct) {
                const int j = 16 * ct + fr; const float gC = __builtin_amdgcn_exp2f(lgC[ct]); const float kkc = kkr[ct], kac = kar[ct];
                float nb[4], kh[4], ktv[4], rtv[4], btv[4], kdv[4];
                float gprev = __builtin_amdgcn_exp2f(lg[ct][0] - dl[ct][0]);
#pragma unroll
                for (int rg = 0; rg < 4; ++rg) {
                    const float kappa = kx[ct][rg] * kkc * inv[rg], a_ = av[ct][rg], beta = kappa * a_, kd = kx[ct][rg] * (1.f + (a_ - 1.f) * kac);
                    const float g = __builtin_amdgcn_exp2f(lg[ct][rg]), gi = __builtin_amdgcn_rcpf(g), gcr = gC * gi;
                    ktv[rg] = gprev * kappa; rtv[rg] = g * rx[ct][rg]; btv[rg] = gi * beta; kdv[rg] = gi * kd;
                    nb[rg] = -beta * gcr; kh[rg] = kd * gcr; gprev = g;
                }
                *(LAS u32x2*)(KT + j * 16 + 4 * fg) = (u32x2){pk2(ktv[0], ktv[1]), pk2(ktv[2], ktv[3])}; *(LAS u32x2*)(RT + j * 16 + 4 * fg) = (u32x2){pk2(rtv[0], rtv[1]), pk2(rtv[2], rtv[3])};
                *(LAS u32x2*)(BT + j * 16 + 4 * fg) = (u32x2){pk2(btv[0], btv[1]), pk2(btv[2], btv[3])}; *(LAS u32x2*)(KDT + j * 16 + 4 * fg) = (u32x2){pk2(kdv[0], kdv[1]), pk2(kdv[2], kdv[3])};
                *(LAS u32x4*)(BH + j * 32 + 8 * fg) = (u32x4){pk2(nb[0], nb[1]), pk2(nb[2], nb[3]), pk2(kh[0], kh[1]), pk2(kh[2], kh[3])};
                *(LAS u32x2*)(VT + j * 16 + 4 * fg) = vraw[ct];
                if (fg == 0) GC[j] = gC;
            }
            asm volatile("s_waitcnt lgkmcnt(0)" ::: "memory");
            CK_BAR(); ++nbar;
            {
                f32x4 g00 = (f32x4){0.f, 0.f, 0.f, 0.f}, g01 = g00, g10 = g00, g11 = g00;
#pragma unroll
                for (int ks = 0; ks < 2; ++ks) {
                    const int j0 = 32 * ks + 8 * fg;
                    const bf16x8 ab = mk8(tr4(BT, j0, fr), tr4(BT, j0 + 4, fr)), ak = mk8(tr4(KDT, j0, fr), tr4(KDT, j0 + 4, fr));
                    const bf16x8 bk = mk8(tr4(KT, j0, fr), tr4(KT, j0 + 4, fr)), br = mk8(tr4(RT, j0, fr), tr4(RT, j0 + 4, fr));
                    g00 = __builtin_amdgcn_mfma_f32_16x16x32_bf16(ab, bk, g00, 0, 0, 0); g01 = __builtin_amdgcn_mfma_f32_16x16x32_bf16(ab, br, g01, 0, 0, 0);
                    g10 = __builtin_amdgcn_mfma_f32_16x16x32_bf16(ak, bk, g10, 0, 0, 0); g11 = __builtin_amdgcn_mfma_f32_16x16x32_bf16(ak, br, g11, 0, 0, 0);
                }
                float nk[4], mb[4], mk[4];
                int fro = fr, fgo = fg; asm volatile("" : "+v"(fro), "+v"(fgo));
#pragma unroll
                for (int rg = 0; rg < 4; ++rg) { const int m = 4 * fgo + rg, n = fro;
                    nk[rg] = (m < n) ? g10[rg] : 0.f; mb[rg] = (m <= n) ? -g01[rg] : 0.f; mk[rg] = (m <= n) ? g11[rg] : 0.f; }
                *(LAS u32x2*)(NKT + fr * 16 + 4 * fg) = (u32x2){pk2(nk[0], nk[1]), pk2(nk[2], nk[3])};
                *(LAS u32x4*)(MT + fr * 32 + 8 * fg) = (u32x4){pk2(mb[0], mb[1]), pk2(mb[2], mb[3]), pk2(mk[0], mk[1]), pk2(mk[2], mk[3])};
                float n0 = g00[0], n1 = g00[1], n2 = g00[2], n3 = g00[3];
                asm volatile("s_nop 15\n\ts_nop 15" : "+v"(n0), "+v"(n1), "+v"(n2), "+v"(n3));
                float Tr[16];
#pragma unroll
                for (int s = 0; s < 16; ++s) { if (s > 0) asm volatile("" : "+v"(n0), "+v"(n1), "+v"(n2), "+v"(n3) : "v"(Tr[s > 0 ? s - 1 : 0]));
                    float a0 = (fro == s) ? 1.f : 0.f, a1 = 0.f, a2 = 0.f, a3 = 0.f;
#pragma unroll
                    for (int r = 0; r < s; r += 4) {
                        const int ln = s + 16 * (r >> 2);
                        const float q0 = __builtin_bit_cast(float, __builtin_amdgcn_readlane(__builtin_bit_cast(int, n0), ln));
                        const float q1 = (r + 1 < s) ? __builtin_bit_cast(float, __builtin_amdgcn_readlane(__builtin_bit_cast(int, n1), ln)) : 0.f;
                        const float q2 = (r + 2 < s) ? __builtin_bit_cast(float, __builtin_amdgcn_readlane(__builtin_bit_cast(int, n2), ln)) : 0.f;
                        const float q3 = (r + 3 < s) ? __builtin_bit_cast(float, __builtin_amdgcn_readlane(__builtin_bit_cast(int, n3), ln)) : 0.f;
                        a0 -= Tr[r] * q0; if (r + 1 < s) a1 -= Tr[r + 1] * q1; if (r + 2 < s) a2 -= Tr[r + 2] * q2; if (r + 3 < s) a3 -= Tr[r + 3] * q3; }
                    Tr[s] = (a0 + a1) + (a2 + a3); __builtin_amdgcn_sched_barrier(0); }
                if (lane < 16) {
#pragma unroll
                    for (int s = 0; s < 16; s += 8) *(LAS u32x4*)(TT + fr * 16 + s) = (u32x4){pk2(Tr[s], Tr[s + 1]), pk2(Tr[s + 2], Tr[s + 3]), pk2(Tr[s + 4], Tr[s + 5]), pk2(Tr[s + 6], Tr[s + 7])};
                }
            }
            asm volatile("s_waitcnt lgkmcnt(0)" ::: "memory");
            CK_BAR(); ++nbar;
        }
        for (; nbar < NBAR; ++nbar) CK_BAR();
#undef CK_LOAD
    }
    __syncthreads();
}
#undef CK_BAR
#undef CS_SLOT

struct NaState { bf16x8 qf[4][2]; f32x4 oacc[4][4]; float mrun[4], lrun[4]; int mbq[4]; };
template <int MODE> __device__ __forceinline__ constexpr bool na_need(int qt, int T) {
    if (MODE == 2) return true;
    const int kt = 2 * MODE + T;
    return qt == 0 ? (kt <= 1) : qt == 1 ? (kt <= 2) : qt == 2 ? (kt >= 1) : (kt >= 2);
}
struct NaLd { u32x4 kr[4]; int krow0; };
__device__ __forceinline__ void na_load(NaLd& ld, const bf16_t* Z, int krow0, int h, int lane, int fr, int fg) {
    ld.krow0 = krow0;
#pragma unroll
    for (int i = 0; i < 4; ++i) { const int p = lane + 64 * i, kk = p >> 3, d0 = (p & 7) * 8; ld.kr[i] = *(const u32x4*)(Z + (size_t)(krow0 + kk) * DINP + ZNK + 64 * h + d0); }
}
template <int MODE, bool FOLD> __device__ __forceinline__ void na_slice(NaState& st, NaLd& ld, int nrow0, const bf16_t* Z, int h, int dr, LAS bf16_t* Vt, const LAS float* bias, int lane, int fr, int fg) {
    const int krow0 = ld.krow0;
    u32x4 vv[4];
#pragma unroll
    for (int i = 0; i < 4; ++i) { const int p = lane + 64 * i, kk = p >> 3, d0 = (p & 7) * 8; vv[i] = *(const u32x4*)(Z + (size_t)(krow0 + kk) * DINP + ZNV + 64 * h + d0); }
    LAS bf16_t* Kt = Vt + 32 * 72;
#pragma unroll
    for (int i = 0; i < 4; ++i) { const int p = lane + 64 * i, kk = p >> 3, d0 = (p & 7) * 8; *(LAS u32x4*)(Kt + kk * 72 + d0) = ld.kr[i]; }
    if (nrow0 >= 0) na_load(ld, Z, nrow0, h, lane, fr, fg);
    f32x4 sacc[2][4];
#pragma unroll
    for (int T = 0; T < 2; ++T) {
#pragma unroll
        for (int qt = 0; qt < 4; ++qt) { const float c0_ = FOLD ? -st.mrun[qt] : 0.f; sacc[T][qt] = (f32x4){c0_, c0_, c0_, c0_}; }
#pragma unroll
        for (int ks = 0; ks < 2; ++ks) { const bf16x8 kf = *(const LAS bf16x8*)(Kt + (16 * T + fr) * 72 + 32 * ks + 8 * fg);
#pragma unroll
            for (int qt = 0; qt < 4; ++qt) if (na_need<MODE>(qt, T)) sacc[T][qt] = __builtin_amdgcn_mfma_f32_16x16x32_bf16(kf, st.qf[qt][ks], sacc[T][qt], 0, 0, 0); }
    }
#pragma unroll
    for (int i = 0; i < 4; ++i) { const int p = lane + 64 * i, kk = p >> 3, d0 = (p & 7) * 8; *(LAS u32x4*)(Vt + kk * 72 + d0) = vv[i]; }
#define NA_QT(qt) (na_need<MODE>(qt, 0) || na_need<MODE>(qt, 1))
    float mxv[4];
#pragma unroll
    for (int qt = 0; qt < 4; ++qt) if (NA_QT(qt)) {
        float mx = -3.0e38f;
        const int mb_ = (int)(short)(st.mbq[qt] & 0xffff), bq_ = st.mbq[qt] >> 16;
        const LAS float* bp = bias + dr * 31 + 32 * MODE + bq_;
#pragma unroll
        for (int T = 0; T < 2; ++T) if (na_need<MODE>(qt, T))
#pragma unroll
            for (int rg = 0; rg < 4; ++rg) {
                float s = sacc[T][qt][rg];
                if (MODE != 2) { const unsigned u = (unsigned)(32 * MODE + 16 * T + rg + mb_); const float bv = bp[16 * T + rg];
                    s = (u < 16u) ? s + bv : -1.0e30f; }
                sacc[T][qt][rg] = s; mx = fmaxf(mx, s);
            }
        mxv[qt] = mx;
    }
    bool grow = false;
#pragma unroll
    for (int qt = 0; qt < 4; ++qt) if (NA_QT(qt)) grow = grow || (FOLD ? (mxv[qt] > 8.0f) : (mxv[qt] > st.mrun[qt] + 8.0f));
    if (__builtin_amdgcn_ballot_w64(grow) != 0ull) {
#pragma unroll
        for (int qt = 0; qt < 4; ++qt) if (NA_QT(qt)) mxv[qt] = fmaxf(mxv[qt], __shfl_xor(mxv[qt], 16));
#pragma unroll
        for (int qt = 0; qt < 4; ++qt) if (NA_QT(qt)) mxv[qt] = fmaxf(mxv[qt], __shfl_xor(mxv[qt], 32));
#pragma unroll
        for (int qt = 0; qt < 4; ++qt) if (NA_QT(qt)) {
            float alpha;
            if (FOLD) { const float d = fmaxf(mxv[qt], 0.f); alpha = __builtin_amdgcn_exp2f(-d); st.mrun[qt] += d;
#pragma unroll
                for (int T = 0; T < 2; ++T) sacc[T][qt] = sacc[T][qt] - d; }
            else { const float mnew = fmaxf(st.mrun[qt], mxv[qt]); alpha = __builtin_amdgcn_exp2f(st.mrun[qt] - mnew); st.mrun[qt] = mnew; }
            st.lrun[qt] *= alpha;
#pragma unroll
            for (int dt = 0; dt < 4; ++dt) st.oacc[dt][qt] = st.oacc[dt][qt] * alpha;
        }
    }
    bf16x8 vf[4];
    {
        const LAS bf16_t* vb = Vt + (4 * fg + ((lane & 15) >> 2)) * 72 + 4 * (lane & 3);
#pragma unroll
        for (int dt = 0; dt < 4; ++dt) {
            typedef short s16x4 __attribute__((ext_vector_type(4)));
            const s16x4 lo = __builtin_amdgcn_ds_read_tr16_b64_v4i16((LAS s16x4*)(vb + 16 * dt)), hi = __builtin_amdgcn_ds_read_tr16_b64_v4i16((LAS s16x4*)(vb + 16 * 72 + 16 * dt));
            vf[dt] = (bf16x8){lo[0], lo[1], lo[2], lo[3], hi[0], hi[1], hi[2], hi[3]};
        }
    }
#pragma unroll
    for (int qt = 0; qt < 4; ++qt) if (NA_QT(qt)) {
        float ps = 0.f; const float mr = st.mrun[qt];
#pragma unroll
        for (int T = 0; T < 2; ++T)
#pragma unroll
            for (int rg = 0; rg < 4; ++rg) { if (na_need<MODE>(qt, T)) { const float e = __builtin_amdgcn_exp2f(FOLD ? sacc[T][qt][rg] : sacc[T][qt][rg] - mr); sacc[T][qt][rg] = e; ps += e; } else sacc[T][qt][rg] = 0.f; }
        st.lrun[qt] += ps;
        u32x4 o; o.x = pk2(sacc[0][qt][0], sacc[0][qt][1]); o.y = pk2(sacc[0][qt][2], sacc[0][qt][3]); o.z = pk2(sacc[1][qt][0], sacc[1][qt][1]); o.w = pk2(sacc[1][qt][2], sacc[1][qt][3]);
        const bf16x8 pfq = __builtin_bit_cast(bf16x8, o);
#pragma unroll
        for (int dt = 0; dt < 4; ++dt) st.oacc[dt][qt] = __builtin_amdgcn_mfma_f32_16x16x32_bf16(vf[dt], pfq, st.oacc[dt][qt], 0, 0, 0);
    }
#undef NA_QT
    asm volatile("s_waitcnt lgkmcnt(0)" ::: "memory");
}
__device__ __forceinline__ void na_unit(Frame& F, int layer, int b, int h, int r, bool ctxq) {
    const bf16_t* Z = (const bf16_t*)(FWS(F) + WS_Z);
    bf16_t* Y = (bf16_t*)(FWS(F) + WS_H);
    const int lane = F.lane, fr = lane & 15, fg = lane >> 4;
    LAS unsigned char* wl = F.lds + F.wave * 12288;
    LAS bf16_t* Vt = (LAS bf16_t*)wl;
    LAS float* bias = (LAS float*)(wl + 9728);
    const float SC2 = 0.125f * 1.4426950408889634f;
    if (!ctxq) { const float* rp = F.tab[I_RPB] + ((size_t)layer * 8 + h) * 465; float bv[8];
#pragma unroll
        for (int it = 0; it < 8; ++it) { const int i = lane + 64 * it; bv[it] = rp[i < 465 ? i : 464]; }
#pragma unroll
        for (int it = 0; it < 8; ++it) { const int i = lane + 64 * it; if (i < 465) bias[i] = bv[it] * 1.4426950408889634f; } }
    const int qrow0 = ctxq ? NLAT + b * CTXL + r * 64 : b * SEQ + r * 64;
    NaState st;
#pragma unroll
    for (int qt = 0; qt < 4; ++qt) {
#pragma unroll
        for (int ks = 0; ks < 2; ++ks) { const u32x4 w = *(const u32x4*)(Z + (size_t)(qrow0 + 16 * qt + fr) * DINP + ZNQ + 64 * h + 32 * ks + 8 * fg); float f[8]; unpack8(w, f);
            u32x4 o; o.x = pk2(f[0] * SC2, f[1] * SC2); o.y = pk2(f[2] * SC2, f[3] * SC2); o.z = pk2(f[4] * SC2, f[5] * SC2); o.w = pk2(f[6] * SC2, f[7] * SC2); st.qf[qt][ks] = __builtin_bit_cast(bf16x8, o); }
        const int cq = 16 * qt + fr, c0 = min(max(cq - 8, 0), 48);
        st.mbq[qt] = ((4 * fg - c0) & 0xffff) | ((4 * fg - cq + 15) << 16);
        st.mrun[qt] = -3.0e38f; st.lrun[qt] = 0.f;
#pragma unroll
        for (int dt = 0; dt < 4; ++dt) st.oacc[dt][qt] = (f32x4){0.f, 0.f, 0.f, 0.f};
    }
    NaLd la;
    const int crow = NLAT + b * CTXL;
    if (!ctxq) {
        const int row0 = min(max(r - 4, 0), 24), kbase = b * SEQ + row0 * 64;
        na_load(la, Z, kbase, h, lane, fr, fg);
#pragma nounroll
        for (int i = 0; i < 8; ++i) {
            const int dr = row0 + i - r + 7;
            na_slice<0, false>(st, la, kbase + 64 * i + 32, Z, h, dr, Vt, bias, lane, fr, fg);
            na_slice<1, false>(st, la, i < 7 ? kbase + 64 * (i + 1) : crow, Z, h, dr, Vt, bias, lane, fr, fg);
        }
#pragma nounroll
        for (int j = 0; j < 8; ++j) na_slice<2, true>(st, la, j + 1 < 8 ? crow + 32 * (j + 1) : -1, Z, h, 0, Vt, bias, lane, fr, fg);
    } else {
        na_load(la, Z, crow, h, lane, fr, fg);
#pragma nounroll
        for (int j = 0; j < 8; ++j) na_slice<2, false>(st, la, j + 1 < 8 ? crow + 32 * (j + 1) : -1, Z, h, 0, Vt, bias, lane, fr, fg);
    }
#pragma unroll
    for (int qt = 0; qt < 4; ++qt) { float lr = st.lrun[qt]; lr += __shfl_xor(lr, 16); lr += __shfl_xor(lr, 32); const float il = 1.0f / lr;
#pragma unroll
        for (int dt = 0; dt < 4; ++dt) { const f32x4 o = st.oacc[dt][qt] * il; u32x2 w; w.x = pk2(o[0], o[1]); w.y = pk2(o[2], o[3]);
            *(u32x2*)(Y + (size_t)(qrow0 + 16 * qt + fr) * D + RWW + 64 * h + 16 * dt + 4 * fg) = w; } }
}

__device__ __forceinline__ void sc_items(Frame& F, int layer, size_t it0, size_t it1, size_t gt, size_t GT) {
    const bf16_t* Z = (const bf16_t*)(FWS(F) + WS_Z); bf16_t* Y = (bf16_t*)(FWS(F) + WS_H);
    const float* cw = F.tab[I_SCW] + (size_t)layer * 3 * SCW;
    for (size_t it = it0 + gt; it < it1; it += GT) {
        const int row = (int)(it >> 5), c0 = (int)(it & 31) * 8;
        const int tpos = row < NLAT ? (row & (SEQ - 1)) : ((row - NLAT) & (CTXL - 1)); const int tlen = row < NLAT ? SEQ : CTXL;
        const bf16_t* zr = Z + (size_t)row * DINP;
        float zb[8], u0[8], u1[8], u2[8], t0[8], t1[8];
        unpack8(*(const u32x4*)(zr + ZSB + c0), zb);
        unpack8(*(const u32x4*)(zr + ZSC + c0), t0); unpack8(*(const u32x4*)(zr + ZSX + c0), t1);
#pragma unroll
        for (int j = 0; j < 8; ++j) u1[j] = t0[j] * t1[j];
        if (tpos > 0) { unpack8(*(const u32x4*)(zr - DINP + ZSC + c0), t0); unpack8(*(const u32x4*)(zr - DINP + ZSX + c0), t1);
#pragma unroll
            for (int j = 0; j < 8; ++j) u0[j] = t0[j] * t1[j]; } else {
#pragma unroll
            for (int j = 0; j < 8; ++j) u0[j] = 0.f; }
        if (tpos < tlen - 1) { unpack8(*(const u32x4*)(zr + DINP + ZSC + c0), t0); unpack8(*(const u32x4*)(zr + DINP + ZSX + c0), t1);
#pragma unroll
            for (int j = 0; j < 8; ++j) u2[j] = t0[j] * t1[j]; } else {
#pragma unroll
            for (int j = 0; j < 8; ++j) u2[j] = 0.f; }
        float o[8];
#pragma unroll
        for (int j = 0; j < 8; ++j) o[j] = zb[j] * (u0[j] * cw[c0 + j] + u1[j] * cw[SCW + c0 + j] + u2[j] * cw[2 * SCW + c0 + j]);
        u32x4 w; w.x = pk2(o[0], o[1]); w.y = pk2(o[2], o[3]); w.z = pk2(o[4], o[5]); w.w = pk2(o[6], o[7]);
        *(u32x4*)(Y + (size_t)row * D + RWW + NAW + c0) = w;
    }
}

#ifndef REPMASK
#define REPMASK 0
#endif
__device__ __forceinline__ void mixer_phase(Frame& F, int layer) {
    const bool need_ctx = layer == 0;
    const size_t scn = (size_t)(need_ctx ? NTOK : NLAT) * 32, sc1 = (scn * 3 / 4) & ~(size_t)31;
    if (F.bid < 128) { for (int rep = 0; rep < 1 + ((REPMASK >> 10) & 1); ++rep) scan_chunked(F, layer, F.bid >> 3, (F.bid >> 1) & 3, F.bid & 1);
        sc_items(F, layer, sc1, scn, (size_t)F.bid * NTHR + F.tid, (size_t)128 * NTHR); }
    else sc_items(F, layer, 0, sc1, (size_t)(F.bid - 128) * NTHR + F.tid, (size_t)(F.G - 128) * NTHR);
    unsigned* ctr = (unsigned*)(FWS(F) + WS_CTL + 14336) + 64 * layer;
    const unsigned nun = NB * 32 * 8 + (need_ctx ? NB * 4 * 8 : 0);
    for (;;) {
        unsigned u = 0; if (F.lane == 0) u = __hip_atomic_fetch_add(ctr, 1u, __ATOMIC_RELAXED, __HIP_MEMORY_SCOPE_AGENT);
        u = (unsigned)__builtin_amdgcn_readfirstlane((int)u);
        if (u >= nun) break;
        if (u < NB * 32 * 8) na_unit(F, layer, u >> 8, u & 7, (u >> 3) & 31, false);
        else { const unsigned v = u - NB * 32 * 8; na_unit(F, layer, v >> 5, v & 7, (v >> 3) & 3, true); }
    }
}

__device__ __forceinline__ void rwkv_post_phase(Frame& F, int layer, int nrows) {
    const bf16_t* Z = (const bf16_t*)(FWS(F) + WS_Z); bf16_t* Y = (bf16_t*)(FWS(F) + WS_H);
    const bf16_t* YS0 = (const bf16_t*)(FWS(F) + WS_YS); const bf16_t* YS1 = YS0 + (size_t)NTOK * RWW;
    LAS bf16_t* gT = (LAS bf16_t*)F.lds;
    LAS bf16_t* gtile = (LAS bf16_t*)(F.lds + 256 * 272) + F.wave * (16 * 72);
    { const float* src = F.tab[I_RGUP] + (size_t)layer * 128 * 256;
      f32x4 gv[16];
#pragma unroll
      for (int it = 0; it < 16; ++it) gv[it] = *(const f32x4*)(src + 4 * (F.tid + NTHR * it));
#pragma unroll
      for (int it = 0; it < 16; ++it) { const int i4 = 4 * (F.tid + NTHR * it), k = i4 >> 8, ch = i4 & 255; const unsigned w0 = pk2(gv[it][0], gv[it][1]), w1 = pk2(gv[it][2], gv[it][3]);
          gT[ch * 136 + k] = (bf16_t)(w0 & 0xffffu); gT[(ch + 1) * 136 + k] = (bf16_t)(w0 >> 16); gT[(ch + 2) * 136 + k] = (bf16_t)(w1 & 0xffffu); gT[(ch + 3) * 136 + k] = (bf16_t)(w1 >> 16); } }
    __syncthreads();
    const int lane = F.lane, fr = lane & 15, fg = lane >> 4;
    const int tl = lane >> 2, q16 = (lane & 3) * 16;
    const int gw = F.bid * NWAVES + F.wave, NGW = F.G * NWAVES;
    const int nitems = (nrows / 16) * 4;
    for (int it = gw; it < nitems; it += NGW) {
        const int h = it & 3, row0 = (it >> 2) * 16;
        const size_t row = (size_t)row0 + tl; const int c0 = 64 * h + q16;
        u32x4 zg[4];
#pragma unroll
        for (int ks = 0; ks < 4; ++ks) zg[ks] = *(const u32x4*)(Z + (size_t)(row0 + fr) * DINP + ZG + 32 * ks + 8 * fg);
        const bf16_t* zr = Z + row * DINP + c0;
        const u32x4 ya0 = *(const u32x4*)(YS0 + row * RWW + c0), ya1 = *(const u32x4*)(YS0 + row * RWW + c0 + 8), yb0 = *(const u32x4*)(YS1 + row * RWW + c0), yb1 = *(const u32x4*)(YS1 + row * RWW + c0 + 8);
        const u32x4 wr0 = *(const u32x4*)(zr + ZR), wr1 = *(const u32x4*)(zr + ZR + 8), wk0 = *(const u32x4*)(zr + ZK), wk1 = *(const u32x4*)(zr + ZK + 8), wv0 = *(const u32x4*)(zr + ZV), wv1 = *(const u32x4*)(zr + ZV + 8);
        bf16x8 af[4];
#pragma unroll
        for (int ks = 0; ks < 4; ++ks) { float f[8]; unpack8(zg[ks], f);
            u32x4 o; o.x = pk2(fsigmoid(f[0]), fsigmoid(f[1])); o.y = pk2(fsigmoid(f[2]), fsigmoid(f[3])); o.z = pk2(fsigmoid(f[4]), fsigmoid(f[5])); o.w = pk2(fsigmoid(f[6]), fsigmoid(f[7])); af[ks] = __builtin_bit_cast(bf16x8, o); }
#pragma unroll
        for (int nt = 0; nt < 4; ++nt) {
            f32x4 acc = (f32x4){0.f, 0.f, 0.f, 0.f};
#pragma unroll
            for (int ks = 0; ks < 4; ++ks) acc = __builtin_amdgcn_mfma_f32_16x16x32_bf16(af[ks], *(const LAS bf16x8*)(gT + (64 * h + 16 * nt + fr) * 136 + 32 * ks + 8 * fg), acc, 0, 0, 0);
#pragma unroll
            for (int rg = 0; rg < 4; ++rg) gtile[(4 * fg + rg) * 72 + 16 * nt + fr] = (bf16_t)f2bf(acc[rg]);
        }
        asm volatile("s_waitcnt lgkmcnt(0)" ::: "memory");
        float y[16];
        { float ta[8], tb[8]; unpack8(ya0, ta); unpack8(yb0, tb);
#pragma unroll
          for (int e = 0; e < 8; ++e) y[e] = ta[e] + tb[e];
          unpack8(ya1, ta); unpack8(yb1, tb);
#pragma unroll
          for (int e = 0; e < 8; ++e) y[8 + e] = ta[e] + tb[e]; }
        float s1 = 0.f;
#pragma unroll
        for (int j = 0; j < 16; ++j) s1 += y[j];
        s1 += dppf<XOR1>(s1); s1 += dppf<XOR2>(s1);
        const float mu = s1 * (1.f / 64.f);
        float s2 = 0.f;
#pragma unroll
        for (int j = 0; j < 16; ++j) { y[j] -= mu; s2 += y[j] * y[j]; }
        s2 += dppf<XOR1>(s2); s2 += dppf<XOR2>(s2);
        const float rs = rsqrtf(s2 * (1.f / 64.f) + 64e-5f);
        float r[16], k[16], v[16], gte[16];
        { float t[8]; unpack8(wr0, t);
#pragma unroll
          for (int j = 0; j < 8; ++j) r[j] = t[j];
          unpack8(wr1, t);
#pragma unroll
          for (int j = 0; j < 8; ++j) r[8 + j] = t[j];
          unpack8(wk0, t);
#pragma unroll
          for (int j = 0; j < 8; ++j) k[j] = t[j];
          unpack8(wk1, t);
#pragma unroll
          for (int j = 0; j < 8; ++j) k[8 + j] = t[j];
          unpack8(wv0, t);
#pragma unroll
          for (int j = 0; j < 8; ++j) v[j] = t[j];
          unpack8(wv1, t);
#pragma unroll
          for (int j = 0; j < 8; ++j) v[8 + j] = t[j];
          unpack8(*(const LAS u32x4*)(gtile + tl * 72 + q16), t);
#pragma unroll
          for (int j = 0; j < 8; ++j) gte[j] = t[j];
          unpack8(*(const LAS u32x4*)(gtile + tl * 72 + q16 + 8), t);
#pragma unroll
          for (int j = 0; j < 8; ++j) gte[8 + j] = t[j]; }
        const float* lnx = F.tab[I_RLNX] + (size_t)layer * 256 + c0; const float* rk = F.tab[I_RRK] + (size_t)layer * 256 + c0;
        float bon = 0.f;
#pragma unroll
        for (int j = 0; j < 16; ++j) bon += r[j] * k[j] * rk[j];
        bon += dppf<XOR1>(bon); bon += dppf<XOR2>(bon);
        unsigned ow[8];
#pragma unroll
        for (int j = 0; j < 16; j += 2) { const float o0 = (y[j] * rs * lnx[j] + v[j] * bon) * gte[j], o1 = (y[j + 1] * rs * lnx[j + 1] + v[j + 1] * bon) * gte[j + 1]; ow[j >> 1] = pk2(o0, o1); }
        *(u32x4*)(Y + row * D + c0) = (u32x4){ow[0], ow[1], ow[2], ow[3]}; *(u32x4*)(Y + row * D + c0 + 8) = (u32x4){ow[4], ow[5], ow[6], ow[7]};
        asm volatile("s_waitcnt lgkmcnt(0)" ::: "memory");
    }
    __syncthreads();
}
__device__ __forceinline__ unsigned mono_of(float x) { const unsigned u = __builtin_bit_cast(unsigned, x); return u ^ ((unsigned)((int)u >> 31) | 0x80000000u); }
__device__ __forceinline__ float unmono(unsigned m) { const unsigned u = m ^ (~(unsigned)((int)m >> 31) | 0x80000000u); return __builtin_bit_cast(float, u); }
#define KCE(a, b) do { const unsigned _hi = (a) > (b) ? (a) : (b), _lo = (a) > (b) ? (b) : (a); (a) = _hi; (b) = _lo; } while (0)
__device__ __forceinline__ void ksort16(unsigned (&k)[16]) {
    KCE(k[0], k[1]); KCE(k[2], k[3]); KCE(k[0], k[2]); KCE(k[1], k[3]); KCE(k[1], k[2]); KCE(k[4], k[5]); KCE(k[6], k[7]); KCE(k[4], k[6]); KCE(k[5], k[7]); KCE(k[5], k[6]); KCE(k[0], k[4]); KCE(k[2], k[6]); KCE(k[2], k[4]); KCE(k[1], k[5]); KCE(k[3], k[7]); KCE(k[3], k[5]); KCE(k[1], k[2]); KCE(k[3], k[4]); KCE(k[5], k[6]); KCE(k[8], k[9]); KCE(k[10], k[11]); KCE(k[8], k[10]); KCE(k[9], k[11]); KCE(k[9], k[10]); KCE(k[12], k[13]); KCE(k[14], k[15]); KCE(k[12], k[14]); KCE(k[13], k[15]); KCE(k[13], k[14]); KCE(k[8], k[12]); KCE(k[10], k[14]); KCE(k[10], k[12]); KCE(k[9], k[13]); KCE(k[11], k[15]); KCE(k[11], k[13]); KCE(k[9], k[10]); KCE(k[11], k[12]); KCE(k[13], k[14]); KCE(k[0], k[8]); KCE(k[4], k[12]); KCE(k[4], k[8]); KCE(k[2], k[10]); KCE(k[6], k[14]); KCE(k[6], k[10]); KCE(k[2], k[4]); KCE(k[6], k[8]); KCE(k[10], k[12]); KCE(k[1], k[9]); KCE(k[5], k[13]); KCE(k[5], k[9]); KCE(k[3], k[11]); KCE(k[7], k[15]); KCE(k[7], k[11]); KCE(k[3], k[5]); KCE(k[7], k[9]); KCE(k[11], k[13]); KCE(k[1], k[2]); KCE(k[3], k[4]); KCE(k[5], k[6]); KCE(k[7], k[8]); KCE(k[9], k[10]); KCE(k[11], k[12]); KCE(k[13], k[14]);
}
__device__ __forceinline__ void kmerge16(unsigned (&a)[16], const unsigned (&b)[16]) {
#pragma unroll
    for (int i = 0; i < 16; ++i) a[i] = a[i] > b[15 - i] ? a[i] : b[15 - i];
#pragma unroll
    for (int stride = 8; stride > 0; stride >>= 1)
#pragma unroll
        for (int i = 0; i < 16; ++i) { const int j = i ^ stride; if (j > i) KCE(a[i], a[j]); }
}
__host__ __device__ constexpr int cand_slot(int a, int b) { int n = 0; for (int x = 0; x < 16; ++x) for (int y = 0; y < 16; ++y) { if (x == a && y == b) return n; if ((x + 1) * (y + 1) <= 16) ++n; } return n; }

namespace pg8 {
struct EpiTopk {
    static constexpr bool PERM = false, AFTER_DRAIN = true;
    int* IDX; float* GATE;
    __device__ __forceinline__ void dump(const f32x4 (&a)[2][4][2], LAS float* T, int wr, int wc, int fr, int fq) const {
#pragma unroll
        for (int bj = 0; bj < 2; ++bj)
#pragma unroll
            for (int m = 0; m < 4; ++m)
#pragma unroll
                for (int n = 0; n < 2; ++n) { LAS float* p = T + (wr * 64 + m * 16 + fr) * 257 + bj * HALF + wc * 32 + n * 16 + 4 * fq;
                    p[0] = a[bj][m][n][0]; p[1] = a[bj][m][n][1]; p[2] = a[bj][m][n][2]; p[3] = a[bj][m][n][3]; }
    }
    __device__ __forceinline__ void fused(f32x4 (&acc)[2][2][4][2], const Unit& u, int wr_, int wc_, int fr_, int fq_, LAS unsigned char* lds, int wid_, int lane_) const {
        LAS float* T = (LAS float*)lds;
        LAS unsigned* LX = (LAS unsigned*)lds;
        LAS unsigned* LF = (LAS unsigned*)lds + 256 * 17;
        int tid = threadIdx.x; asm volatile("" : "+v"(tid));
        const int lane = tid & 63, wid = tid >> 6, wr = wid >> 2, wc = wid & 3, fr = lane & 15, fq = lane >> 4;
        const int row = tid & 127, p = (tid >> 7) & 1, hf = tid >> 8;
#pragma nounroll
        for (int ai = 0; ai < 2; ++ai) {
            if (ai == 0) dump(acc[0], T, wr, wc, fr, fq); else dump(acc[1], T, wr, wc, fr, fq);
            __syncthreads();
            unsigned top[16];
            {
                const LAS float* src = T + row * 257 + p * 128 + hf * 64;
#pragma nounroll
                for (int g = 0; g < 4; ++g) {
                    unsigned k[16];
#pragma unroll
                    for (int j = 0; j < 16; ++j) k[j] = (mono_of(src[g * 16 + j]) & ~127u) | (unsigned)(127 - (hf * 64 + g * 16 + j));
                    ksort16(k);
                    if (g == 0) {
#pragma unroll
                        for (int j = 0; j < 16; ++j) top[j] = k[j];
                    } else kmerge16(top, k);
                }
            }
            __syncthreads();
            if (hf == 1) {
#pragma unroll
                for (int j = 0; j < 16; ++j) LX[(tid & 255) * 17 + j] = top[j];
            }
            __syncthreads();
            if (hf == 0) {
                unsigned o[16];
#pragma unroll
                for (int j = 0; j < 16; ++j) o[j] = LX[tid * 17 + j];
                kmerge16(top, o);
#pragma unroll
                for (int j = 0; j < 16; ++j) LF[(row * 2 + p) * 17 + j] = top[j];
            }
            __syncthreads();
            if (tid < 128) {
                const LAS unsigned* K1 = LF + (tid * 2) * 17; const LAS unsigned* K2 = K1 + 17;
                float s1[16], s2[16];
#pragma unroll
                for (int j = 0; j < 16; ++j) { s1[j] = unmono(K1[j] & ~127u); s2[j] = unmono(K2[j] & ~127u); }
                unsigned best[16];
#pragma unroll
                for (int g = 0; g < 4; ++g) {
                    unsigned k[16];
#pragma unroll
                    for (int j = 0; j < 16; ++j) k[j] = 0u;
#pragma unroll
                    for (int a = 0; a < 16; ++a)
#pragma unroll
                        for (int b = 0; b < 16; ++b) if ((a + 1) * (b + 1) <= 16) { constexpr int dummy = 0; (void)dummy; const int sl = cand_slot(a, b); if ((sl >> 4) == g) k[sl & 15] = (mono_of(s1[a] + s2[b]) & ~255u) | (unsigned)(255 - (a * 16 + b)); }
                    ksort16(k);
                    if (g == 0) {
#pragma unroll
                        for (int j = 0; j < 16; ++j) best[j] = k[j];
                    } else kmerge16(best, k);
                }
                const float v0 = unmono(best[0] & ~255u); float e[16], es = 0.f;
#pragma unroll
                for (int j = 0; j < 16; ++j) { e[j] = __expf(unmono(best[j] & ~255u) - v0); es += e[j]; }
                const float ies = 1.0f / es;
                const size_t token = (size_t)u.pm * BM + ai * HALF + tid;
                unsigned* io = (unsigned*)IDX + (token * 8 + u.pn) * 16;
#pragma unroll
                for (int j = 0; j < 16; j += 4) {
                    unsigned e4[4];
#pragma unroll
                    for (int q = 0; q < 4; ++q) { const int ab = 255 - (int)(best[j + q] & 255u); const unsigned eid = (unsigned)((127 - (int)(K1[ab >> 4] & 127u)) * PNK + (127 - (int)(K2[ab & 15] & 127u)));
                        e4[q] = eid | (pk2(0.f, e[j + q] * ies) & 0xffff0000u); }
                    *(u32x4*)(io + j) = (u32x4){e4[0], e4[1], e4[2], e4[3]};
                }
            }
            __syncthreads();
        }
    }
};
}

__device__ __forceinline__ float wave_total(float v) {
    v += dppf<XOR1>(v); v += dppf<XOR2>(v); v += dppf<XOR7>(v); v += dppf<ROR8>(v);
    v += __builtin_bit_cast(float, __builtin_amdgcn_update_dpp(0, __builtin_bit_cast(int, v), 0x142, 0xa, 0xf, false));
    v += __builtin_bit_cast(float, __builtin_amdgcn_update_dpp(0, __builtin_bit_cast(int, v), 0x143, 0xc, 0xf, false));
    return __builtin_bit_cast(float, __builtin_amdgcn_readlane(__builtin_bit_cast(int, v), 63));
}
typedef int i32x8 __attribute__((ext_vector_type(8)));
__device__ __forceinline__ void peer_expert_phase(Frame& F, int layer, int nrows, const float* mod, float oscale, int fuse_next, int idmask = 0x3fff) {
    const bf16_t* H = (const bf16_t*)(FWS(F) + WS_H);
    const unsigned char* PU8 = FWS(F) + WS_PU + (size_t)layer * (16 * MiB);
    const f32x2* SC2 = (const f32x2*)(FWS(F) + WS_PSC) + (size_t)layer * PN;
    const unsigned* IDX = (const unsigned*)(FWS(F) + WS_IDX);
    bf16_t* XR = (bf16_t*)(FWS(F) + WS_XR);
    const int lane = F.lane, gw = F.bid * NWAVES + F.wave, NGW = F.G * NWAVES;
    const int mcol = lane & 15, g = lane >> 4;
    LAS unsigned char* wl = F.lds + F.wave * 17408;
    { unsigned z = 0u; asm volatile("" : "+v"(z)); *(LAS u32x2*)(wl + 8192 + 8 * lane) = (u32x2){z, z}; }
    LAS unsigned char* wlu = wl + 8704; const unsigned urd = (unsigned)(mcol * 528 + g * 16);
    const unsigned lane8 = 8u * (unsigned)lane;
    const int ntw = gw < nrows ? (nrows - gw + NGW - 1) / NGW : 0;
    for (int g0 = 0; g0 < ntw; g0 += 4) {
        const int nt = ntw - g0 < 4 ? ntw - g0 : 4;
        unsigned s0[4], s1[4]; float invs[4];
        u32x4 hx[4][2]; unsigned r0[4], r1[4];
#pragma unroll
        for (int t = 0; t < 4; ++t) { const int row = gw + (g0 + (t < nt ? t : 0)) * NGW;
            hx[t][0] = *(const u32x4*)(H + (size_t)row * D + 16 * lane); hx[t][1] = *(const u32x4*)(H + (size_t)row * D + 16 * lane + 8);
            r0[t] = IDX[(size_t)row * 128 + lane]; r1[t] = IDX[(size_t)row * 128 + 64 + lane]; }
#pragma unroll
        for (int t = 0; t < 4; ++t) if (t < nt) {
            float xf[16];
            { float tt[8]; unpack8(hx[t][0], tt);
#pragma unroll
              for (int j = 0; j < 8; ++j) xf[j] = tt[j];
              unpack8(hx[t][1], tt);
#pragma unroll
              for (int j = 0; j < 8; ++j) xf[8 + j] = tt[j]; }
            float mx = 0.f;
#pragma unroll
            for (int j = 0; j < 16; ++j) mx = fmaxf(mx, fabsf(xf[j]));
            mx = wave_max(mx);
            int se = 255 - (int)((__builtin_bit_cast(unsigned, mx) >> 23) & 0xffu); se = se > 250 ? 250 : se;
            const float xs = __builtin_bit_cast(float, (unsigned)se << 23); invs[t] = __builtin_bit_cast(float, (unsigned)(254 - se) << 23);
            {
                float y[16];
#pragma unroll
                for (int j = 0; j < 16; ++j) y[j] = xf[j] * xs;
#pragma unroll
                for (int st = 0; st < 4; ++st) {
                    unsigned w0 = 0u, w1 = 0u;
                    w0 = __builtin_amdgcn_cvt_scalef32_pk_fp4_f32(w0, y[0], y[1], 1.0f, 0); w0 = __builtin_amdgcn_cvt_scalef32_pk_fp4_f32(w0, y[2], y[3], 1.0f, 1);
                    w0 = __builtin_amdgcn_cvt_scalef32_pk_fp4_f32(w0, y[4], y[5], 1.0f, 2); w0 = __builtin_amdgcn_cvt_scalef32_pk_fp4_f32(w0, y[6], y[7], 1.0f, 3);
                    w1 = __builtin_amdgcn_cvt_scalef32_pk_fp4_f32(w1, y[8], y[9], 1.0f, 0); w1 = __builtin_amdgcn_cvt_scalef32_pk_fp4_f32(w1, y[10], y[11], 1.0f, 1);
                    w1 = __builtin_amdgcn_cvt_scalef32_pk_fp4_f32(w1, y[12], y[13], 1.0f, 2); w1 = __builtin_amdgcn_cvt_scalef32_pk_fp4_f32(w1, y[14], y[15], 1.0f, 3);
                    *(LAS u32x2*)(wl + t * 2048 + st * 512 + 8 * lane) = (u32x2){w0, w1};
                    if (st < 3) {
                        f32x2 d;
                        d = __builtin_amdgcn_cvt_scalef32_pk_f32_fp4(w0, 1.0f, 0); y[0] = (y[0] - d.x) * 8.0f; y[1] = (y[1] - d.y) * 8.0f;
                        d = __builtin_amdgcn_cvt_scalef32_pk_f32_fp4(w0, 1.0f, 1); y[2] = (y[2] - d.x) * 8.0f; y[3] = (y[3] - d.y) * 8.0f;
                        d = __builtin_amdgcn_cvt_scalef32_pk_f32_fp4(w0, 1.0f, 2); y[4] = (y[4] - d.x) * 8.0f; y[5] = (y[5] - d.y) * 8.0f;
                        d = __builtin_amdgcn_cvt_scalef32_pk_f32_fp4(w0, 1.0f, 3); y[6] = (y[6] - d.x) * 8.0f; y[7] = (y[7] - d.y) * 8.0f;
                        d = __builtin_amdgcn_cvt_scalef32_pk_f32_fp4(w1, 1.0f, 0); y[8] = (y[8] - d.x) * 8.0f; y[9] = (y[9] - d.y) * 8.0f;
                        d = __builtin_amdgcn_cvt_scalef32_pk_f32_fp4(w1, 1.0f, 1); y[10] = (y[10] - d.x) * 8.0f; y[11] = (y[11] - d.y) * 8.0f;
                        d = __builtin_amdgcn_cvt_scalef32_pk_f32_fp4(w1, 1.0f, 2); y[12] = (y[12] - d.x) * 8.0f; y[13] = (y[13] - d.y) * 8.0f;
                        d = __builtin_amdgcn_cvt_scalef32_pk_f32_fp4(w1, 1.0f, 3); y[14] = (y[14] - d.x) * 8.0f; y[15] = (y[15] - d.y) * 8.0f;
                    }
                }
            }
            {
                const int q0 = (int)((r0[t] & 0xffffu) >> 11), q1 = (int)((r1[t] & 0xffffu) >> 11);
                int base = 0, p0 = 0, p1 = 0;
#pragma unroll
                for (int r = 0; r < 8; ++r) {
                    const unsigned long long b0 = __builtin_amdgcn_ballot_w64(q0 == r), b1 = __builtin_amdgcn_ballot_w64(q1 == r);
                    const int c0 = __builtin_popcountll(b0), c1 = __builtin_popcountll(b1);
                    const int m0 = (int)__builtin_amdgcn_mbcnt_hi((unsigned)(b0 >> 32), __builtin_amdgcn_mbcnt_lo((unsigned)b0, 0u)), m1 = (int)__builtin_amdgcn_mbcnt_hi((unsigned)(b1 >> 32), __builtin_amdgcn_mbcnt_lo((unsigned)b1, 0u));
                    if (q0 == r) p0 = base + m0;
                    if (q1 == r) p1 = base + c0 + m1;
                    base += c0 + c1;
                }
                LAS unsigned* tmp = (LAS unsigned*)wlu;
                tmp[p0] = r0[t]; tmp[p1] = r1[t];
                asm volatile("s_waitcnt lgkmcnt(0)" ::: "memory");
                s0[t] = tmp[lane]; s1[t] = tmp[64 + lane];
                asm volatile("s_waitcnt lgkmcnt(0)" ::: "memory");
            }
        } else { s0[t] = 0u; s1[t] = 0u; invs[t] = 0.f; }
        f32x2 o2[4][8];
#pragma unroll
        for (int t = 0; t < 4; ++t)
#pragma unroll
            for (int j = 0; j < 8; ++j) o2[t][j] = (f32x2){0.f, 0.f};
        float su0, gv0; u32x2 uq[16], vq[16];
        { const unsigned pwc = (unsigned)__shfl((int)s0[0], mcol);
          const int id0 = (int)(pwc & 0xffffu) & idmask; const f32x2 s2 = SC2[id0]; su0 = s2.x; gv0 = bfhi(pwc) * s2.y;
#pragma unroll
          for (int k = 0; k < 16; ++k) { const int e = __builtin_amdgcn_readlane((int)pwc, k) & 0xffff & idmask; unsigned v8 = lane8; asm volatile("" : "+v"(v8));
              uq[k] = *(const u32x2*)(PU8 + (size_t)e * 1024 + v8); }
#pragma unroll
          for (int k = 0; k < 16; ++k) { const int e = __builtin_amdgcn_readlane((int)pwc, k) & 0xffff & idmask; unsigned v8 = lane8; asm volatile("" : "+v"(v8));
              vq[k] = *(const u32x2*)(PU8 + (size_t)e * 1024 + 512 + v8); } }
#pragma nounroll
        for (int b = 0; b < 8; ++b) {
#pragma unroll
            for (int t = 0; t < 4; ++t) if (t < nt) {
                unsigned pwn;
                { const bool wrap = (t + 1 >= nt); const int bn = wrap ? (b + 1 < 8 ? b + 1 : b) : b;
                  const unsigned a0 = wrap ? s0[0] : s0[(t + 1) & 3], a1 = wrap ? s1[0] : s1[(t + 1) & 3];
                  pwn = (unsigned)__shfl((int)((bn & 4) ? a1 : a0), 16 * (bn & 3) + mcol); }
                unsigned v8o = lane8; asm volatile("" : "+v"(v8o));
#pragma unroll
                for (int k = 0; k < 16; ++k) *(LAS u32x2*)(wlu + k * 528 + lane8) = uq[k];
                f32x4 c = (f32x4){0.f, 0.f, 0.f, 0.f};
                const unsigned ard = mcol < 4 ? (unsigned)(t * 2048 + mcol * 512 + g * 16) : 8192u;
#pragma unroll
                for (int kb = 0; kb < 8; ++kb) { const u32x4 xa = *(const LAS u32x4*)(wl + ard + kb * 64), ub = *(const LAS u32x4*)(wlu + urd + kb * 64);
                    c = __builtin_amdgcn_mfma_scale_f32_16x16x128_f8f6f4((i32x8){(int)xa.x, (int)xa.y, (int)xa.z, (int)xa.w, 0, 0, 0, 0}, (i32x8){(int)ub.x, (int)ub.y, (int)ub.z, (int)ub.w, 0, 0, 0, 0}, c,
                                                                         4  , 4  , 0, 0x7f7f7f7f, 0, 0x7f7f7f7f); }
                const float T = (c[0] + c[1] * 0.125f) + (c[2] * 0.015625f + c[3] * 0.001953125f);
                const int id1 = (int)(pwn & 0xffffu) & idmask;
                const f32x2 s21 = SC2[id1];
#pragma unroll
                for (int k = 0; k < 16; ++k) { const int e1 = __builtin_amdgcn_readlane((int)pwn, k) & 0xffff & idmask; unsigned v8 = lane8; asm volatile("" : "+v"(v8));
                    uq[k] = *(const u32x2*)(PU8 + (size_t)e1 * 1024 + v8); }
                const float av = T * (su0 * invs[t]);
                const float wv = gv0 * av * __builtin_amdgcn_rcpf(1.0f + __expf(-1.5957691216057308f * (av + 0.044715f * av * av * av)));
#pragma unroll
                for (int k = 0; k < 16; ++k) {
                    const float w = __builtin_bit_cast(float, __builtin_amdgcn_readlane(__builtin_bit_cast(int, wv), k));
#pragma unroll
                    for (int wd = 0; wd < 2; ++wd) {
                        const unsigned wq = vq[k][wd];
                        o2[t][4 * wd] += __builtin_amdgcn_cvt_scalef32_pk_f32_fp4(wq, 1.0f, 0) * w; o2[t][4 * wd + 1] += __builtin_amdgcn_cvt_scalef32_pk_f32_fp4(wq, 1.0f, 1) * w;
                        o2[t][4 * wd + 2] += __builtin_amdgcn_cvt_scalef32_pk_f32_fp4(wq, 1.0f, 2) * w; o2[t][4 * wd + 3] += __builtin_amdgcn_cvt_scalef32_pk_f32_fp4(wq, 1.0f, 3) * w;
                    }
                    const int e1 = __builtin_amdgcn_readlane((int)pwn, k) & 0xffff & idmask;
                    vq[k] = *(const u32x2*)(PU8 + (size_t)e1 * 1024 + 512 + v8o);
                }
#pragma unroll
                for (int j = 0; j < 8; ++j) asm volatile("" : "+v"(o2[t][j]));
                __builtin_amdgcn_sched_barrier(0);
                su0 = s21.x; gv0 = bfhi(pwn) * s21.y;
            }
        }
#pragma unroll
        for (int t = 0; t < 4; ++t) if (t < nt) {
            const int row = gw + (g0 + t) * NGW;
            float o[16];
#pragma unroll
            for (int j = 0; j < 8; ++j) { o[2 * j] = o2[t][j].x; o[2 * j + 1] = o2[t][j].y; }
            const bool isc = row >= NLAT; const int mrow = isc ? 16 : row / SEQ;
            bf16_t* xr = XR + (size_t)row * D + 16 * lane;
            const float* g2 = mod + (size_t)mrow * 6144 + 5 * 1024 + 16 * lane;
            f32x4 xn[4]; float ssq = 0.f;
            { float xo[16]; float tt[8]; unpack8(*(const u32x4*)xr, tt);
#pragma unroll
              for (int j = 0; j < 8; ++j) xo[j] = tt[j];
              unpack8(*(const u32x4*)(xr + 8), tt);
#pragma unroll
              for (int j = 0; j < 8; ++j) xo[8 + j] = tt[j];
#pragma unroll
              for (int q = 0; q < 4; ++q) { const f32x4 gg = *(const f32x4*)(g2 + 4 * q);
                  xn[q] = (f32x4){xo[4 * q], xo[4 * q + 1], xo[4 * q + 2], xo[4 * q + 3]} + gg * oscale * (f32x4){o[4 * q], o[4 * q + 1], o[4 * q + 2], o[4 * q + 3]};
                  ssq += (xn[q][0] * xn[q][0] + xn[q][1] * xn[q][1]) + (xn[q][2] * xn[q][2] + xn[q][3] * xn[q][3]); } }
            if (fuse_next != 2) {
                *(u32x4*)xr = (u32x4){pk2(xn[0][0], xn[0][1]), pk2(xn[0][2], xn[0][3]), pk2(xn[1][0], xn[1][1]), pk2(xn[1][2], xn[1][3])};
                *(u32x4*)(xr + 8) = (u32x4){pk2(xn[2][0], xn[2][1]), pk2(xn[2][2], xn[2][3]), pk2(xn[3][0], xn[3][1]), pk2(xn[3][2], xn[3][3])};
            }
            if (fuse_next != 0) {
                const float rs = rsqrtf(wave_total(ssq) * (1.f / D) + 1e-6f);
                if (fuse_next == 1) {
                    const float* gn = F.tab[I_N1G] + (size_t)(layer + 1) * D + 16 * lane; const float* shn = mod + (size_t)17 * 6144 + (size_t)mrow * 6144 + 16 * lane;
                    unsigned w[8];
#pragma unroll
                    for (int q = 0; q < 4; ++q) {
                        const f32x4 y = xn[q] * rs * *(const f32x4*)(gn + 4 * q) * (*(const f32x4*)(shn + 1024 + 4 * q) + 1.0f) + *(const f32x4*)(shn + 4 * q);
                        w[2 * q] = pk2(y[0], y[1]); w[2 * q + 1] = pk2(y[2], y[3]);
                    }
                    bf16_t* hr = (bf16_t*)(FWS(F) + WS_H) + (size_t)row * D + 16 * lane;
                    *(u32x4*)hr = (u32x4){w[0], w[1], w[2], w[3]}; *(u32x4*)(hr + 8) = (u32x4){w[4], w[5], w[6], w[7]};
                } else {
                    const float* gf = F.tab[I_FING] + 16 * lane; float* orow = FOUT(F) + (size_t)row * D + 16 * lane;
#pragma unroll
                    for (int q = 0; q < 4; ++q) *(f32x4*)(orow + 4 * q) = xn[q] * rs * *(const f32x4*)(gf + 4 * q);
                }
            }
        }
    }
}

__device__ __forceinline__ void final_norm_phase(Frame& F) {
    const int gw = F.bid * NWAVES + F.wave, NGW = F.G * NWAVES; const float* g = F.tab[I_FING];
    for (int m = gw; m < NLAT; m += NGW) {
        f32x4* xr = (f32x4*)(FOUT(F) + (size_t)m * D) + F.lane;
        f32x4 v[4]; float s = 0.f;
#pragma unroll
        for (int j = 0; j < 4; ++j) { v[j] = xr[64 * j]; s += (v[j].x * v[j].x + v[j].y * v[j].y) + (v[j].z * v[j].z + v[j].w * v[j].w); }
        const float rs = rsqrtf(wave_sum(s) * (1.f / D) + 1e-6f);
#pragma unroll
        for (int j = 0; j < 4; ++j) xr[64 * j] = v[j] * rs * ((const f32x4*)g + F.lane)[64 * j];
    }
}

__global__ void __launch_bounds__(NTHR, 2) mega(Args args) {
    extern __shared__ __attribute__((aligned(16))) unsigned char lds_raw[];
    cg::grid_group grid = cg::this_grid();
    Frame F;
    F.lds = (LAS unsigned char*)lds_raw;
    F.tid = threadIdx.x; F.lane = F.tid & 63; F.wave = __builtin_amdgcn_readfirstlane(F.tid >> 6); F.G = gridDim.x; F.bid = blockIdx.x;
    F.tab = (ktab_t)__builtin_amdgcn_kernarg_segment_ptr();
    volatile LAS unsigned* xst = (volatile LAS unsigned*)(F.lds + LDS_BYTES - 64);
    if (threadIdx.x < 2) xst[threadIdx.x] = 0u;
    __syncthreads();
    const XcdBarrier xbar = xcd_barrier_post((unsigned*)(FWS(F) + WS_CTL), xst);
    const float* MOD = (const float*)(FWS(F) + WS_MOD);
    bf16_t* H = (bf16_t*)(FWS(F) + WS_H); bf16_t* Zb = (bf16_t*)(FWS(F) + WS_Z); bf16_t* Qb = (bf16_t*)(FWS(F) + WS_Q);
#define REFRESH() do { int _t = threadIdx.x; asm volatile("" : "+v"(_t)); F.tid = _t; F.lane = _t & 63; F.wave = __builtin_amdgcn_readfirstlane(_t >> 6); ktab_t _kt = F.tab; asm volatile("" : "+s"(_kt)); F.tab = _kt; } while (0)
#define GSYNC() do { xcd_barrier(xbar); REFRESH(); } while (0)
#define GSYNC_CG() do { __threadfence(); grid.sync(); REFRESH(); } while (0)

#ifndef REPMASK
#define REPMASK 0
#endif
#ifndef PROBE_IDMASK
#define PROBE_IDMASK 0x3fff
#endif
#ifndef PEER_OSCALE
#define PEER_OSCALE 1.0f
#endif
#define NREP(k) (1 + ((REPMASK >> (k)) & 1))
    for (int rep = 0; rep < NREP(0); ++rep) { p0_prologue(F);
        if (args.pad0 == 0x5eed) GSYNC_CG();
        GSYNC(); }
    for (int layer = 0; layer < 2; ++layer) {
        const bool need_ctx = layer == 0;
        const float* mod = MOD + (size_t)layer * 17 * 6144;
        const float* xl_in = F.tab[I_X]; const float* xc_in = F.tab[I_CTX];
        const int nrows2 = need_ctx ? NTOK : NLAT;
        if (layer == 0) for (int rep = 0; rep < NREP(1); ++rep) { norm_mod_phase(F, xl_in, xc_in, F.tab[I_N1G] + (size_t)layer * D, mod, 0, NTOK); GSYNC(); }
        for (int rep = 0; rep < NREP(2); ++rep) { pg8::Gemm g{H, (const bf16_t*)(FWS(F) + WS_WIN) + (size_t)layer * DINP * D, D, D, 0}; pg8::StaticOrder S; S.init(NTOK / 256, DINP / 256, F.G, F.bid);
          pg8::EpiBf16 E{Zb, DINP}; pg8::gemm_phase<pg8::EpiBf16, pg8::StaticOrder, true>(F.lds, g, S, E); GSYNC(); }
        for (int rep = 0; rep < NREP(3); ++rep) { mixer_phase(F, layer); GSYNC(); }
        for (int rep = 0; rep < NREP(4); ++rep) { rwkv_post_phase(F, layer, nrows2); GSYNC(); }
        for (int rep = 0; rep < NREP(5); ++rep) { pg8::Gemm g{H, (const bf16_t*)(FWS(F) + WS_WOUT) + (size_t)layer * D * D, D, D, 0}; pg8::StaticOrder S; S.init(nrows2 / 256, D / 256, F.G, F.bid);
          if (layer == 0) { pg8::EpiRes<false> E{xl_in, xc_in, (bf16_t*)(FWS(F) + WS_XR), mod + 2 * 1024, (rep + 1 == NREP(5)) ? 1.0f : 0.0f}; pg8::gemm_phase<pg8::EpiRes<false>, pg8::StaticOrder, true>(F.lds, g, S, E);
            if (rep == 0) {
                const int nwg = (nrows2 / 256) * (D / 256), extra = nwg - ((nwg + F.G - 1) / F.G - 1) * F.G;
                if (extra >= F.G) convert_peer_tables(F, PN / 2, PN, F.bid * NWAVES + F.wave, F.G * NWAVES);
                else if (F.bid >= extra) convert_peer_tables(F, PN / 2, PN, (F.bid - extra) * NWAVES + F.wave, (F.G - extra) * NWAVES); } }
          else { pg8::EpiRes<true> E{xl_in, xc_in, (bf16_t*)(FWS(F) + WS_XR), mod + 2 * 1024, (rep + 1 == NREP(5)) ? 1.0f : 0.0f}; pg8::gemm_phase<pg8::EpiRes<true>, pg8::StaticOrder, true>(F.lds, g, S, E); }
          GSYNC(); }
        for (int rep = 0; rep < NREP(6); ++rep) { norm_mod_phase_xr(F, F.tab[I_N2G] + (size_t)layer * D, mod, 3 * 1024, nrows2); GSYNC(); }
        for (int rep = 0; rep < NREP(8); ++rep) { pg8::Gemm g{H, (const bf16_t*)(FWS(F) + WS_QW) + (size_t)layer * 2048 * D, D, D, 0};   pg8::StaticOrder S; S.init(nrows2 / 256, 8, F.G, F.bid);
          pg8::EpiTopk E{(int*)(FWS(F) + WS_IDX), (float*)(FWS(F) + WS_GATE)};
          for (int i = 0;; ++i) { pg8::OneUnit O; if (!S.next(i, O.u)) break; pg8::gemm_phase<pg8::EpiTopk, pg8::OneUnit, false>(F.lds, g, O, E); }
          if (layer == 0 && rep == 0) {
              const int nwg = (nrows2 / 256) * 8, extra = nwg - ((nwg + F.G - 1) / F.G - 1) * F.G;
              if (extra >= F.G) convert_peer_tables(F, PN / 4, PN / 2, F.bid * NWAVES + F.wave, F.G * NWAVES);
              else if (F.bid >= extra) convert_peer_tables(F, PN / 4, PN / 2, (F.bid - extra) * NWAVES + F.wave, (F.G - extra) * NWAVES); }
          GSYNC(); }
        for (int rep = 0; rep < NREP(9); ++rep) { const bool lastrep = (rep + 1 == NREP(9)); peer_expert_phase(F, layer, nrows2, mod, lastrep ? PEER_OSCALE : 0.0f, lastrep ? (layer == 0 ? 1 : 2) : 0, lastrep ? 0x3fff : PROBE_IDMASK); if (layer == 0 || !lastrep) GSYNC(); }
    }
#undef GSYNC
#undef GSYNC_CG
#undef REFRESH
}

extern "C" void kernel_launch(void* const* d_in, const int* in_sizes, int n_in, void* d_out, int out_size, void* d_ws, size_t ws_size, hipStream_t stream) {
    static int grid = 0;
    if (grid == 0) {
        int dev = 0, cus = 0, per_cu = 0;
        if (n_in != 26 || out_size != NLAT * D || ws_size < WS_END) { fprintf(stderr, "kernel_launch: unexpected shapes (n_in %d, out %d, ws %zu, need %zu)\n", n_in, out_size, ws_size, (size_t)WS_END); grid = -1; return; }
        if (hipGetDevice(&dev) != hipSuccess || hipDeviceGetAttribute(&cus, hipDeviceAttributeMultiprocessorCount, dev) != hipSuccess) { grid = -1; return; }
        if (hipFuncSetAttribute((const void*)mega, hipFuncAttributeMaxDynamicSharedMemorySize, LDS_BYTES) != hipSuccess) { fprintf(stderr, "kernel_launch: hipFuncSetAttribute failed\n"); grid = -1; return; }
        if (hipOccupancyMaxActiveBlocksPerMultiprocessor(&per_cu, (const void*)mega, NTHR, LDS_BYTES) != hipSuccess || per_cu < 1) { fprintf(stderr, "kernel_launch: occupancy query says %d\n", per_cu); grid = -1; return; }
        grid = cus;
        fprintf(stderr, "kernel_launch: grid %d (per_cu %d), ws %zu\n", grid, per_cu, ws_size);
    }
    if (grid < 0) return;
    if (hipMemsetAsync((char*)d_ws + WS_CTL, 0, 16384, stream) != hipSuccess) { fprintf(stderr, "kernel_launch: memset failed\n"); return; }
    Args a{};
    for (int i = 0; i < 26; ++i) a.in[i] = (const float*)d_in[i];
    a.out = (float*)d_out; a.ws = (unsigned char*)d_ws;
    void* kargs[] = {&a};
    hipError_t e = hipLaunchCooperativeKernel((const void*)mega, dim3(grid), dim3(NTHR), kargs, LDS_BYTES, stream);
    if (e != hipSuccess) fprintf(stderr, "cooperative launch failed: %s (grid %d)\n", hipGetErrorString(e), grid);
}
```
